# Optimizing an MI355X kernel written in HIP

```python
import jax, jax.numpy as jnp
from jax import lax
import numpy as np

D_MODEL = 1024
BATCH = 8
SEQ = 2048
DEPTH = 1

LRU_WIDTH = 1024
LRU_BLOCKS = 16
LRU_BLOCK_W = LRU_WIDTH // LRU_BLOCKS
CONV_WIDTH = 4
LRU_C = 8.0
HEAD_DIM = 64
N_Q_HEADS = 16
N_KV_HEADS = 4
Q_PER_KV = N_Q_HEADS // N_KV_HEADS
ATTN_WIDTH = N_Q_HEADS * HEAD_DIM
KV_WIDTH = N_KV_HEADS * HEAD_DIM
WINDOW = 128
BLOCK = 128
ROPE_THETA = 10000.0
D_FF = 2816
MACARON_SCALE = 0.5
NORM_EPS = 1e-6
MASK_VALUE = -1e30
IN_WIDTH = 2 * LRU_WIDTH + ATTN_WIDTH + 2 * KV_WIDTH + 2 * D_MODEL
IN_SPLITS = (
    LRU_WIDTH,
    2 * LRU_WIDTH,
    2 * LRU_WIDTH + ATTN_WIDTH,
    2 * LRU_WIDTH + ATTN_WIDTH + KV_WIDTH,
    2 * LRU_WIDTH + ATTN_WIDTH + 2 * KV_WIDTH,
    2 * LRU_WIDTH + ATTN_WIDTH + 2 * KV_WIDTH + D_MODEL,
)

kernel_name = "hybrid_rglru_swa_sink_macaron_block"


def rms_norm(x, g):
    xf = x.astype(jnp.float32)
    y = xf * lax.rsqrt(jnp.mean(xf * xf, axis=-1, keepdims=True) + NORM_EPS)
    return (y * g.astype(jnp.float32)).astype(x.dtype)


def swiglu(x, w_gu, w_down):
    g, u = jnp.split(x @ w_gu, 2, axis=-1)
    return (jax.nn.silu(g) * u) @ w_down


def rope_tables(seq_len):
    half = HEAD_DIM // 2
    inv_freq = ROPE_THETA ** (-jnp.arange(half, dtype=jnp.float32) / half)
    ang = jnp.arange(seq_len, dtype=jnp.float32)[:, None] * inv_freq[None, :]
    return jnp.cos(ang), jnp.sin(ang)


def apply_rope(x, cos, sin):
    half = HEAD_DIM // 2
    xf = x.astype(jnp.float32)
    x1, x2 = xf[..., :half], xf[..., half:]
    c = cos[None, :, None, :]
    s = sin[None, :, None, :]
    return jnp.concatenate([x1 * c - x2 * s, x2 * c + x1 * s], axis=-1).astype(x.dtype)


def causal_depthwise_conv(x, w, b):
    s = x.shape[1]
    xp = jnp.pad(x, ((0, 0), (CONV_WIDTH - 1, 0), (0, 0)))
    y = xp[:, 0:s] * w[0]
    for k in range(1, CONV_WIDTH):
        y = y + xp[:, k:k + s] * w[k]
    return y + b


def block_diag_linear(x, w, b):
    bsz, s, _ = x.shape
    xb = x.reshape(bsz, s, LRU_BLOCKS, LRU_BLOCK_W)
    y = jnp.einsum('bsnc,ncd->bsnd', xb, w).reshape(bsz, s, LRU_WIDTH)
    return y + b


def rg_lru(x, w_a, b_a, w_x, b_x, lam):
    xf = x.astype(jnp.float32)
    r = jax.nn.sigmoid(block_diag_linear(x, w_a, b_a).astype(jnp.float32))
    i = jax.nn.sigmoid(block_diag_linear(x, w_x, b_x).astype(jnp.float32))
    log_a = -LRU_C * r * jax.nn.softplus(-lam.astype(jnp.float32))
    a = jnp.exp(log_a)
    mult = jnp.sqrt(jnp.maximum(-jnp.expm1(2.0 * log_a), 0.0))
    bterm = mult * (i * xf)

    def combine(left, right):
        a1, b1 = left
        a2, b2 = right
        return a1 * a2, a2 * b1 + b2

    _, h = lax.associative_scan(combine, (a, bterm), axis=1)
    return h.astype(x.dtype)


def band_blocks(t):
    bsz, s, h, d = t.shape
    tb = t.reshape(bsz, s // BLOCK, BLOCK, h, d)
    prev = jnp.pad(tb, ((0, 0), (1, 0), (0, 0), (0, 0), (0, 0)))[:, :-1]
    return jnp.concatenate([prev, tb], axis=2)


def sliding_window_attention_with_sinks(q, k, v, sinks):
    bsz, s = q.shape[0], q.shape[1]
    nb = s // BLOCK
    qb = q.reshape(bsz, nb, BLOCK, N_KV_HEADS, Q_PER_KV, HEAD_DIM)
    kb = band_blocks(k)
    vb = band_blocks(v)
    scores = jnp.einsum('bnqhgd,bnshd->bhgnqs', qb, kb).astype(jnp.float32) * (HEAD_DIM ** -0.5)
    qi = jnp.arange(BLOCK)[:, None]
    si = jnp.arange(2 * BLOCK)[None, :]
    diff = BLOCK + qi - si
    key_pos = (jnp.arange(nb)[:, None, None] - 1) * BLOCK + si[None]
    mask = ((diff >= 0) & (diff < WINDOW))[None] & (key_pos >= 0)
    scores = jnp.where(mask, scores, MASK_VALUE)
    sink = sinks.astype(jnp.float32).reshape(1, N_KV_HEADS, Q_PER_KV, 1, 1, 1)
    sink = jnp.broadcast_to(sink, scores.shape[:-1] + (1,))
    probs = jax.nn.softmax(jnp.concatenate([scores, sink], axis=-1), axis=-1)[..., :-1]
    out = jnp.einsum('bhgnqs,bnshd->bnqhgd', probs.astype(v.dtype), vb)
    return out.reshape(bsz, s, ATTN_WIDTH)


def hybrid_mixer(u, cos, sin, w_in, conv_w, conv_b, lru_w_a, lru_b_a, lru_w_x, lru_b_x,
                 lru_lambda, attn_sinks, w_proj_lru, w_proj_attn, w_out):
    bsz, s, _ = u.shape
    z = u @ w_in
    gate_br, x_br, q, k, v, g_lru, g_attn = jnp.split(z, IN_SPLITS, axis=-1)
    xc = causal_depthwise_conv(x_br, conv_w, conv_b)
    y_lru = rg_lru(xc, lru_w_a, lru_b_a, lru_w_x, lru_b_x, lru_lambda) * jax.nn.gelu(gate_br)
    q = apply_rope(q.reshape(bsz, s, N_Q_HEADS, HEAD_DIM), cos, sin)
    k = apply_rope(k.reshape(bsz, s, N_KV_HEADS, HEAD_DIM), cos, sin)
    v = v.reshape(bsz, s, N_KV_HEADS, HEAD_DIM)
    y_attn = sliding_window_attention_with_sinks(q, k, v, attn_sinks)
    merged = jax.nn.sigmoid(g_lru) * (y_lru @ w_proj_lru) + jax.nn.sigmoid(g_attn) * (y_attn @ w_proj_attn)
    return merged @ w_out


def setup_inputs(seed: int = 0) -> dict:
    key = jax.random.key(seed)
    ks = jax.random.split(key, 24)

    def nrm(k, shape, scale):
        return jax.random.normal(k, shape, jnp.float32) * scale

    def gain(k, shape):
        return 1.0 + 0.05 * jax.random.normal(k, shape, jnp.float32)

    u = jax.random.uniform(ks[13], (DEPTH, LRU_WIDTH), jnp.float32, minval=0.9, maxval=0.999)
    a0 = u ** (1.0 / LRU_C)
    lam = jnp.log(a0) - jnp.log1p(-a0)
    return {
        "x": nrm(ks[0], (BATCH, SEQ, D_MODEL), 1.0),
        "ffn1_pre_g": gain(ks[1], (DEPTH, D_MODEL)),
        "ffn1_w_gu": nrm(ks[2], (DEPTH, D_MODEL, 2 * D_FF), D_MODEL ** -0.5),
        "ffn1_w_down": nrm(ks[3], (DEPTH, D_FF, D_MODEL), D_FF ** -0.5),
        "ffn1_post_g": gain(ks[4], (DEPTH, D_MODEL)),
        "mix_pre_g": gain(ks[5], (DEPTH, D_MODEL)),
        "w_in": nrm(ks[6], (DEPTH, D_MODEL, IN_WIDTH), D_MODEL ** -0.5),
        "conv_w": nrm(ks[7], (DEPTH, CONV_WIDTH, LRU_WIDTH), CONV_WIDTH ** -0.5),
        "conv_b": nrm(ks[8], (DEPTH, LRU_WIDTH), 0.01),
        "lru_w_a": nrm(ks[9], (DEPTH, LRU_BLOCKS, LRU_BLOCK_W, LRU_BLOCK_W), LRU_BLOCK_W ** -0.5),
        "lru_b_a": nrm(ks[10], (DEPTH, LRU_WIDTH), 0.01),
        "lru_w_x": nrm(ks[11], (DEPTH, LRU_BLOCKS, LRU_BLOCK_W, LRU_BLOCK_W), LRU_BLOCK_W ** -0.5),
        "lru_b_x": nrm(ks[12], (DEPTH, LRU_WIDTH), 0.01),
        "lru_lambda": lam,
        "attn_sinks": nrm(ks[14], (DEPTH, N_Q_HEADS), 0.5),
        "w_proj_lru": nrm(ks[15], (DEPTH, LRU_WIDTH, D_MODEL), LRU_WIDTH ** -0.5),
        "w_proj_attn": nrm(ks[16], (DEPTH, ATTN_WIDTH, D_MODEL), ATTN_WIDTH ** -0.5),
        "w_out": nrm(ks[17], (DEPTH, D_MODEL, D_MODEL), D_MODEL ** -0.5),
        "mix_post_g": gain(ks[18], (DEPTH, D_MODEL)),
        "ffn2_pre_g": gain(ks[19], (DEPTH, D_MODEL)),
        "ffn2_w_gu": nrm(ks[20], (DEPTH, D_MODEL, 2 * D_FF), D_MODEL ** -0.5),
        "ffn2_w_down": nrm(ks[21], (DEPTH, D_FF, D_MODEL), D_FF ** -0.5),
        "ffn2_post_g": gain(ks[22], (DEPTH, D_MODEL)),
    }


def reference(x, ffn1_pre_g, ffn1_w_gu, ffn1_w_down, ffn1_post_g,
              mix_pre_g, w_in, conv_w, conv_b, lru_w_a, lru_b_a, lru_w_x, lru_b_x,
              lru_lambda, attn_sinks, w_proj_lru, w_proj_attn, w_out, mix_post_g,
              ffn2_pre_g, ffn2_w_gu, ffn2_w_down, ffn2_post_g):
    cos, sin = rope_tables(x.shape[1])
    h = x
    for l in range(DEPTH):
        f = swiglu(rms_norm(h, ffn1_pre_g[l]), ffn1_w_gu[l], ffn1_w_down[l])
        h = h + MACARON_SCALE * rms_norm(f, ffn1_post_g[l])
        m = hybrid_mixer(rms_norm(h, mix_pre_g[l]), cos, sin, w_in[l], conv_w[l], conv_b[l],
                         lru_w_a[l], lru_b_a[l], lru_w_x[l], lru_b_x[l], lru_lambda[l],
                         attn_sinks[l], w_proj_lru[l], w_proj_attn[l], w_out[l])
        h = h + rms_norm(m, mix_post_g[l])
        f = swiglu(rms_norm(h, ffn2_pre_g[l]), ffn2_w_gu[l], ffn2_w_down[l])
        h = h + MACARON_SCALE * rms_norm(f, ffn2_post_g[l])
    return h
```

```cpp
#include <hip/hip_runtime.h>
#include <hip/hip_cooperative_groups.h>
#include <cstdio>
#include <cstdint>
namespace cg = cooperative_groups;
namespace pg8 {
#define PG8_LAS __attribute__((address_space(3)))
typedef unsigned short bf16_t;
typedef short bf16x8 __attribute__((ext_vector_type(8)));
typedef float f32x4 __attribute__((ext_vector_type(4)));
typedef unsigned u32x4 __attribute__((ext_vector_type(4)));
constexpr int BM = 256, BK = 64, HALF = 128, HTB = HALF * BK * 2  , STAGE_BYTES = 8 * HTB, NXCD = 8, WGM = 8;

__host__ __device__ __forceinline__ int lds_byte(int r, int c) { const int st = (r >> 4) * 2 + (c >> 5), rr = r & 15, cc = c & 31, ob = rr * 64 + cc * 2; return st * 1024 + (ob ^ (((ob >> 9) & 1) << 5)); }
__host__ __device__ __forceinline__ void stage_rc(int b, int& R, int& C) { const int st = b / 1024, sb = b % 1024, swz = sb ^ (((sb >> 9) & 1) << 5); R = (st >> 1) * 16 + swz / 64; C = (st & 1) * 32 + (swz % 64) / 2; }
__host__ __device__ __forceinline__ int perm32(int rho) { const int n = rho >> 4, i = rho & 15; return 8 * (i >> 2) + 4 * n + (i & 3); }

struct Unit { int pm, pn; };
struct Gemm { const bf16_t* A; const bf16_t* Bt; int M, N, K; };

struct StaticOrder {
    int nM, nN, nwg, G, c;
    __host__ __device__ void init(int M, int N, int G_, int c_) { nM = M / BM; nN = N / BM; nwg = nM * nN; G = G_; c = c_; }
    __host__ __device__ bool next(int i, Unit& u) const {
        const long L = (long)i * G + c; if (L >= nwg) return false;
        int wgid = (int)L; { const int q = nwg / NXCD, r = nwg % NXCD, xcd = wgid % NXCD, off = wgid / NXCD; wgid = (xcd < r ? xcd * (q + 1) : r * (q + 1) + (xcd - r) * q) + off; }
        const int nig = WGM * nN, gid = wgid / nig, fm = gid * WGM, gsz = (nM - fm) < WGM ? (nM - fm) : WGM;
        u.pm = fm + ((wgid % nig) % gsz); u.pn = (wgid % nig) / gsz; return true;
    }
    __device__ __forceinline__ void a_ready(const Unit&) const {}
    __device__ __forceinline__ void done(const Unit&) const {}
};

__device__ __forceinline__ unsigned cvt_pk_bf16(float lo, float hi) { unsigned r; asm volatile("v_cvt_pk_bf16_f32 %0, %1, %2" : "=v"(r) : "v"(lo), "v"(hi)); return r; }
typedef float f32x2 __attribute__((ext_vector_type(2)));
template <class Epi, class Sched, bool ALIGN_EPI = false, bool SP2 = false>
__device__ __forceinline__ void gemm_phase(PG8_LAS unsigned char* lds, const Gemm g, const Sched& S, const Epi& E) {
    const int tid = threadIdx.x, wid = __builtin_amdgcn_readfirstlane(tid >> 6), lane = tid & 63, wr = wid >> 2, wc = wid & 3, fr = lane & 15, fq = lane >> 4;
    const int K = g.K, nt = K / BK;
    unsigned voffA[2], voffB[2];
#pragma unroll
    for (int i = 0; i < 2; ++i) { int R, C; stage_rc(tid * 16 + i * 8192, R, C); const int Rb = Epi::PERM ? ((R & ~31) + perm32(R & 31)) : R;
        voffA[i] = (unsigned)(R * K + C) * 2u; voffB[i] = (unsigned)(Rb * K + C) * 2u; }
    const size_t kstep = (size_t)(BK * 2);
    const size_t hstep = (size_t)HALF * K * 2;
    const size_t tstep = 2 * hstep;
    const unsigned ldsw = (unsigned)wid * 1024u;
    const int aoff = lds_byte(wr * 64 + fr, fq * 8), boff = lds_byte(wc * 32 + fr, fq * 8);
#define PG8_SA(b, h) (((b) * 2 + (h)) * HTB)
#define PG8_SB(b, h) ((4 + (b) * 2 + (h)) * HTB)
#define PG8_STAGE(bufoff, gbase, voff) do { _Pragma("unroll") for (int _i = 0; _i < 2; ++_i) \
        __builtin_amdgcn_global_load_lds((const unsigned*)((const char*)(gbase) + (voff)[_i]), (PG8_LAS unsigned*)(lds + (bufoff) + ldsw + _i * 8192), 16, 0, 0); } while (0)
#define PG8_LDA(dst, b, h) do { _Pragma("unroll") for (int m = 0; m < 4; ++m) _Pragma("unroll") for (int k = 0; k < 2; ++k) dst[m][k] = *(const PG8_LAS bf16x8*)(lds + PG8_SA(b, h) + aoff + m * 2048 + k * 1024); } while (0)
#define PG8_LDB(dst, b, h) do { _Pragma("unroll") for (int n = 0; n < 2; ++n) _Pragma("unroll") for (int k = 0; k < 2; ++k) dst[n][k] = *(const PG8_LAS bf16x8*)(lds + PG8_SB(b, h) + boff + n * 2048 + k * 1024); } while (0)
#define PG8_MMA(ai, bj, At, Bt) do { __builtin_amdgcn_s_setprio(1); _Pragma("unroll") for (int m = 0; m < 4; ++m) _Pragma("unroll") for (int n = 0; n < 2; ++n) _Pragma("unroll") for (int k = 0; k < 2; ++k) \
        acc[ai][bj][m][n] = __builtin_amdgcn_mfma_f32_16x16x32_bf16(Bt[n][k], At[m][k], acc[ai][bj][m][n], 0, 0, 0); __builtin_amdgcn_s_setprio(0); } while (0)
#define PG8_WAIT_V(n) asm volatile("s_waitcnt vmcnt(" #n ")" ::: "memory")
#define PG8_WAIT_L(n) asm volatile("s_waitcnt lgkmcnt(" #n ")" ::: "memory")
#define PG8_BAR __builtin_amdgcn_s_barrier()
#define PG8_SCHED __builtin_amdgcn_sched_barrier(0)
    Unit cur, nxt; int ui = 0;
    if (!S.next(0, cur)) return;
    f32x4 acc[2][2][4][2];
#pragma unroll
    for (int a = 0; a < 2; ++a)
#pragma unroll
        for (int b = 0; b < 2; ++b)
#pragma unroll
            for (int m = 0; m < 4; ++m)
#pragma unroll
                for (int n = 0; n < 2; ++n) acc[a][b][m][n] = (f32x4){0.f, 0.f, 0.f, 0.f};
    bf16x8 At[4][2], B0[2][2], B1[2][2];
    const char* cA = (const char*)g.A + (size_t)cur.pm * tstep; const char* cB = (const char*)g.Bt + (size_t)cur.pn * tstep;
    S.a_ready(cur);
    if constexpr (SP2) {
        PG8_STAGE(PG8_SB(0, 0), cB, voffB); PG8_STAGE(PG8_SB(0, 1), cB + hstep, voffB); PG8_STAGE(PG8_SA(0, 0), cA, voffA); PG8_STAGE(PG8_SA(0, 1), cA + hstep, voffA);
        if (wr == 1) PG8_BAR;
        PG8_WAIT_V(2); PG8_BAR;
        PG8_STAGE(PG8_SB(1, 0), cB + kstep, voffB); PG8_STAGE(PG8_SA(1, 0), cA + kstep, voffA); PG8_STAGE(PG8_SB(1, 1), cB + hstep + kstep, voffB);
        PG8_WAIT_V(6); PG8_BAR;
    } else {
        PG8_STAGE(PG8_SB(0, 0), cB, voffB); PG8_STAGE(PG8_SA(0, 0), cA, voffA); PG8_STAGE(PG8_SB(0, 1), cB + hstep, voffB); PG8_STAGE(PG8_SA(0, 1), cA + hstep, voffA);
        if (wr == 1) PG8_BAR;
        PG8_WAIT_V(4); PG8_BAR;
        PG8_STAGE(PG8_SB(1, 0), cB + kstep, voffB); PG8_STAGE(PG8_SA(1, 0), cA + kstep, voffA); PG8_STAGE(PG8_SB(1, 1), cB + hstep + kstep, voffB);
        PG8_WAIT_V(6); PG8_BAR;
    }
    for (;;) {
        const bool has_next = S.next(ui + 1, nxt);
        const char* nA = has_next ? (const char*)g.A + (size_t)nxt.pm * tstep : cA; const char* nB = has_next ? (const char*)g.Bt + (size_t)nxt.pn * tstep : cB;
        for (int t = 0; t < nt; t += 2) {
            const bool last = (t == nt - 2);
            const char* a1 = cA + (size_t)(t + 1) * kstep;
            const char* a2 = last ? nA : cA + (size_t)(t + 2) * kstep; const char* b2 = last ? nB : cB + (size_t)(t + 2) * kstep;
            const char* a3 = a2 + kstep; const char* b3 = b2 + kstep;
            if (last && has_next) S.a_ready(nxt);
            if constexpr (SP2) {
            PG8_LDB(B0, 0, 0); PG8_LDB(B1, 0, 1); PG8_SCHED; PG8_LDA(At, 0, 0); PG8_STAGE(PG8_SA(1, 1), a1 + hstep, voffA);
            PG8_WAIT_V(8); PG8_WAIT_L(0); PG8_BAR; PG8_MMA(0, 0, At, B0); PG8_MMA(0, 1, At, B1); PG8_BAR; PG8_SCHED;
            PG8_LDA(At, 0, 1); PG8_STAGE(PG8_SB(0, 0), b2, voffB); PG8_STAGE(PG8_SB(0, 1), b2 + hstep, voffB); PG8_STAGE(PG8_SA(0, 0), a2, voffA);
            PG8_WAIT_V(8); PG8_WAIT_L(0); PG8_BAR; PG8_MMA(1, 0, At, B0); PG8_MMA(1, 1, At, B1); PG8_BAR; PG8_SCHED;
            PG8_LDB(B0, 1, 0); PG8_LDB(B1, 1, 1); PG8_SCHED; PG8_LDA(At, 1, 0); PG8_STAGE(PG8_SA(0, 1), a2 + hstep, voffA);
            PG8_WAIT_V(8); PG8_WAIT_L(0); PG8_BAR; PG8_MMA(0, 0, At, B0); PG8_MMA(0, 1, At, B1); PG8_BAR; PG8_SCHED;
            PG8_LDA(At, 1, 1); PG8_STAGE(PG8_SB(1, 0), b3, voffB); PG8_STAGE(PG8_SB(1, 1), b3 + hstep, voffB); PG8_STAGE(PG8_SA(1, 0), a3, voffA);
            PG8_WAIT_V(8); PG8_WAIT_L(0); PG8_BAR; PG8_MMA(1, 0, At, B0); PG8_MMA(1, 1, At, B1); PG8_BAR; PG8_SCHED;
            } else {
            PG8_LDB(B0, 0, 0); PG8_SCHED; PG8_LDA(At, 0, 0); PG8_STAGE(PG8_SA(1, 1), a1 + hstep, voffA);
            PG8_WAIT_L(8); PG8_BAR; PG8_WAIT_L(0); PG8_MMA(0, 0, At, B0); PG8_BAR; PG8_SCHED;
            PG8_LDB(B1, 0, 1); PG8_STAGE(PG8_SB(0, 0), b2, voffB);
            PG8_BAR; PG8_WAIT_L(0); PG8_MMA(0, 1, At, B1); PG8_BAR;
            PG8_LDA(At, 0, 1); PG8_STAGE(PG8_SA(0, 0), a2, voffA);
            PG8_BAR; PG8_WAIT_L(0); PG8_MMA(1, 0, At, B0); PG8_BAR; PG8_SCHED;
            PG8_STAGE(PG8_SB(0, 1), b2 + hstep, voffB);
            PG8_WAIT_V(6); PG8_BAR; PG8_MMA(1, 1, At, B1); PG8_BAR;
            PG8_LDB(B0, 1, 0); PG8_SCHED; PG8_LDA(At, 1, 0); PG8_STAGE(PG8_SA(0, 1), a2 + hstep, voffA);
            PG8_WAIT_L(8); PG8_BAR; PG8_WAIT_L(0); PG8_MMA(0, 0, At, B0); PG8_BAR; PG8_SCHED;
            PG8_LDB(B1, 1, 1); PG8_STAGE(PG8_SB(1, 0), b3, voffB);
            PG8_BAR; PG8_WAIT_L(0); PG8_MMA(0, 1, At, B1); PG8_BAR;
            PG8_LDA(At, 1, 1); PG8_STAGE(PG8_SA(1, 0), a3, voffA);
            PG8_BAR; PG8_WAIT_L(0); PG8_MMA(1, 0, At, B0); PG8_BAR; PG8_SCHED;
            PG8_STAGE(PG8_SB(1, 1), b3 + hstep, voffB);
            PG8_WAIT_V(6); PG8_BAR; PG8_MMA(1, 1, At, B1); PG8_BAR;
            }
        }
        if constexpr (ALIGN_EPI) { if (wr == 0) PG8_BAR; }
        if constexpr (!Epi::AFTER_DRAIN) { E(acc, cur, wr, wc, fr, fq); S.done(cur); }
        if (!has_next) break;
#pragma unroll
        for (int a = 0; a < 2; ++a)
#pragma unroll
            for (int b = 0; b < 2; ++b)
#pragma unroll
                for (int m = 0; m < 4; ++m)
#pragma unroll
                    for (int n = 0; n < 2; ++n) acc[a][b][m][n] = (f32x4){0.f, 0.f, 0.f, 0.f};
        cur = nxt; cA = nA; cB = nB; ++ui;
        if constexpr (ALIGN_EPI) { if (wr == 1) PG8_BAR; }
    }
    PG8_WAIT_V(0);
    if constexpr (!ALIGN_EPI) { if (wr == 0) PG8_BAR; }
    PG8_BAR;
    if constexpr (Epi::AFTER_DRAIN) { E.fused(acc, cur, wr, wc, fr, fq, lds, wid, lane); S.done(cur); }
#undef PG8_SA
#undef PG8_SB
#undef PG8_STAGE
#undef PG8_LDA
#undef PG8_LDB
#undef PG8_MMA
#undef PG8_WAIT_V
#undef PG8_WAIT_L
#undef PG8_BAR
#undef PG8_SCHED
}
}

constexpr int BATCH = 8, SEQ = 2048, D = 1024, M = BATCH * SEQ, DFF = 2816, NGU = 2 * DFF, NIN = 5632;
constexpr float EPS = 1e-6f, LOG2E = 1.4426950408889634f;
constexpr float QSCALE = 0.125f * LOG2E;
constexpr int NWAVES = 8, NTHREADS = 512;
constexpr int LDS_BYTES = 147456;

constexpr size_t MiB = 1u << 20;
constexpr size_t WS_WGU = 0, WS_WD = 11 * MiB, WS_WIN = 17 * MiB, WS_WPL = 28 * MiB, WS_WPA = 30 * MiB, WS_WOUT = 32 * MiB, WS_ROPE = 34 * MiB;
constexpr size_t WS_XN = 36 * MiB;
constexpr size_t WS_GB = 68 * MiB, WS_XB = 100 * MiB, WS_Q = 132 * MiB, WS_K = 164 * MiB, WS_V = 172 * MiB, WS_GL = 180 * MiB, WS_GA = 212 * MiB;
constexpr size_t WS_ACT = 68 * MiB;
constexpr size_t WS_F = 180 * MiB;
constexpr size_t WS_MB = WS_XB;
constexpr size_t WS_END = 244 * MiB;

#define LAS __attribute__((address_space(3)))
typedef unsigned short bf16;
typedef unsigned u32x4 __attribute__((ext_vector_type(4)));
typedef unsigned u32x2 __attribute__((ext_vector_type(2)));
typedef float f32x4 __attribute__((ext_vector_type(4)));
typedef float f32x2 __attribute__((ext_vector_type(2)));
typedef float f32x16 __attribute__((ext_vector_type(16)));
typedef short bf16x8 __attribute__((ext_vector_type(8)));

__device__ __forceinline__ unsigned pk2(float lo, float hi) { return pg8::cvt_pk_bf16(lo, hi); }
__device__ __forceinline__ float bflo(unsigned w) { return __uint_as_float(w << 16); }
__device__ __forceinline__ float bfhi(unsigned w) { return __uint_as_float(w & 0xffff0000u); }
__device__ __forceinline__ float bf2f(bf16 v) { return __uint_as_float((unsigned)v << 16); }
__device__ __forceinline__ float sigmoidf_(float x) { return __builtin_amdgcn_rcpf(1.f + __builtin_amdgcn_exp2f(-x * LOG2E)); }
__device__ __forceinline__ float siluf_(float x) { return x * sigmoidf_(x); }
__device__ __forceinline__ float gelu_tanh_(float x) { const float y = 0.7978845608028654f * (x + 0.044715f * x * x * x); return x * sigmoidf_(2.f * y); }
__device__ __forceinline__ float act_(float v, int act) { return act == 1 ? gelu_tanh_(v) : (act == 2 ? sigmoidf_(v) : v); }
__device__ __forceinline__ float wave_sum(float v) {
#pragma unroll
    for (int o = 1; o < 64; o <<= 1) v += __shfl_xor(v, o);
    return v;
}

namespace pg8 {
struct EpiSwiglu {
    static constexpr bool PERM = true, AFTER_DRAIN = false;
    bf16_t* O;
    __device__ __forceinline__ void operator()(const f32x4 (&acc)[2][2][4][2], const Unit& u, int wr, int wc, int fr, int fq) const {
        const int row0 = u.pm * BM + wr * 64 + fr, col0 = u.pn * 128 + wc * 32 + 8 * fq;
#pragma unroll
        for (int ai = 0; ai < 2; ++ai)
#pragma unroll
            for (int m = 0; m < 4; ++m) {
                bf16_t* p = O + (size_t)(row0 + ai * HALF + m * 16) * DFF + col0;
                const f32x4 g0 = acc[ai][0][m][0], g1 = acc[ai][0][m][1], u0 = acc[ai][1][m][0], u1 = acc[ai][1][m][1];
                u32x4 w;
                w.x = cvt_pk_bf16(siluf_(g0[0]) * u0[0], siluf_(g0[1]) * u0[1]); w.y = cvt_pk_bf16(siluf_(g0[2]) * u0[2], siluf_(g0[3]) * u0[3]);
                w.z = cvt_pk_bf16(siluf_(g1[0]) * u1[0], siluf_(g1[1]) * u1[1]); w.w = cvt_pk_bf16(siluf_(g1[2]) * u1[2], siluf_(g1[3]) * u1[3]);
                *(u32x4*)p = w;
            }
    }
};
struct EpiF32 {
    static constexpr bool PERM = false, AFTER_DRAIN = false;
    float* O; int ldc;
    __device__ __forceinline__ void operator()(const f32x4 (&acc)[2][2][4][2], const Unit& u, int wr, int wc, int fr, int fq) const {
        const int row0 = u.pm * BM + wr * 64 + fr, col0 = u.pn * BM + wc * 32 + 4 * fq;
#pragma unroll
        for (int ai = 0; ai < 2; ++ai)
#pragma unroll
            for (int m = 0; m < 4; ++m) {
                float* p = O + (size_t)(row0 + ai * HALF + m * 16) * ldc + col0;
#pragma unroll
                for (int bj = 0; bj < 2; ++bj)
#pragma unroll
                    for (int n = 0; n < 2; ++n) *(f32x4*)(p + bj * HALF + n * 16) = acc[ai][bj][m][n];
            }
    }
};
struct EpiMix {
    static constexpr bool PERM = true, AFTER_DRAIN = false;
    bf16_t *GB, *XB, *Q, *K, *V, *GL, *GA; const float* rope;
    __device__ __forceinline__ void operator()(const f32x4 (&acc)[2][2][4][2], const Unit& u, int wr, int wc, int fr, int fq) const {
        const int pn = u.pn, row0 = u.pm * BM + wr * 64 + fr;
        if (pn >= 8 && pn <= 12) {
            const bool isq = pn < 12; bf16_t* base = isq ? Q + 256 * (pn - 8) : K; const int ld = isq ? D : 256; const float sc = isq ? QSCALE : 1.f;
            const int dd0 = 8 * fq, col = 64 * wc + dd0;
#pragma unroll
            for (int ai = 0; ai < 2; ++ai)
#pragma unroll
                for (int m = 0; m < 4; ++m) {
                    const int row = row0 + ai * HALF + m * 16, pos = row & (SEQ - 1);
                    const f32x4* tp = (const f32x4*)(rope + (size_t)(pos * 32 + dd0) * 2);
                    const f32x4 t0 = tp[0], t1 = tp[1], t2 = tp[2], t3 = tp[3];
                    const f32x4 xa = acc[ai][0][m][0], xb = acc[ai][0][m][1], ya = acc[ai][1][m][0], yb = acc[ai][1][m][1];
                    float c[8] = {t0[0], t0[2], t1[0], t1[2], t2[0], t2[2], t3[0], t3[2]};
                    float s[8] = {t0[1], t0[3], t1[1], t1[3], t2[1], t2[3], t3[1], t3[3]};
                    float x1[8] = {xa[0], xa[1], xa[2], xa[3], xb[0], xb[1], xb[2], xb[3]};
                    float x2[8] = {ya[0], ya[1], ya[2], ya[3], yb[0], yb[1], yb[2], yb[3]};
                    float o1[8], o2[8];
#pragma unroll
                    for (int j = 0; j < 8; ++j) { o1[j] = (x1[j] * c[j] - x2[j] * s[j]) * sc; o2[j] = (x2[j] * c[j] + x1[j] * s[j]) * sc; }
                    u32x4 w1, w2;
                    w1.x = cvt_pk_bf16(o1[0], o1[1]); w1.y = cvt_pk_bf16(o1[2], o1[3]); w1.z = cvt_pk_bf16(o1[4], o1[5]); w1.w = cvt_pk_bf16(o1[6], o1[7]);
                    w2.x = cvt_pk_bf16(o2[0], o2[1]); w2.y = cvt_pk_bf16(o2[2], o2[3]); w2.z = cvt_pk_bf16(o2[4], o2[5]); w2.w = cvt_pk_bf16(o2[6], o2[7]);
                    bf16_t* p = base + (size_t)row * ld + col;
                    *(u32x4*)p = w1; *(u32x4*)(p + 32) = w2;
                }
        } else {
            bf16_t* base; int ld = D, act = 0;
            if (pn < 4) { base = GB + 256 * pn; act = 1; }
            else if (pn < 8) { base = XB + 256 * (pn - 4); }
            else if (pn == 13) { base = V; ld = 256; }
            else if (pn < 18) { base = GL + 256 * (pn - 14); act = 2; }
            else { base = GA + 256 * (pn - 18); act = 2; }
            const int col0 = wc * 32 + 8 * fq;
#pragma unroll
            for (int ai = 0; ai < 2; ++ai)
#pragma unroll
                for (int m = 0; m < 4; ++m) {
                    bf16_t* p = base + (size_t)(row0 + ai * HALF + m * 16) * ld + col0;
#pragma unroll
                    for (int bj = 0; bj < 2; ++bj) {
                        const f32x4 v0 = acc[ai][bj][m][0], v1 = acc[ai][bj][m][1];
                        u32x4 w;
                        w.x = cvt_pk_bf16(act_(v0[0], act), act_(v0[1], act)); w.y = cvt_pk_bf16(act_(v0[2], act), act_(v0[3], act));
                        w.z = cvt_pk_bf16(act_(v1[0], act), act_(v1[1], act)); w.w = cvt_pk_bf16(act_(v1[2], act), act_(v1[3], act));
                        *(u32x4*)(p + bj * HALF) = w;
                    }
                }
        }
    }
};
template <bool SECOND> struct EpiGate {
    static constexpr bool PERM = true, AFTER_DRAIN = false;
    const bf16_t* G; bf16_t* MB;
    __device__ __forceinline__ void operator()(const f32x4 (&acc)[2][2][4][2], const Unit& u, int wr, int wc, int fr, int fq) const {
        const int row0 = u.pm * BM + wr * 64 + fr, col0 = u.pn * BM + wc * 32 + 8 * fq;
#pragma unroll
        for (int ai = 0; ai < 2; ++ai)
#pragma unroll
            for (int m = 0; m < 4; ++m)
#pragma unroll
                for (int bj = 0; bj < 2; ++bj) {
                    const size_t off = (size_t)(row0 + ai * HALF + m * 16) * D + col0 + bj * HALF;
                    const u32x4 g = *(const u32x4*)(G + off);
                    const f32x4 v0 = acc[ai][bj][m][0], v1 = acc[ai][bj][m][1];
                    float o[8] = {bflo(g.x) * v0[0], bfhi(g.x) * v0[1], bflo(g.y) * v0[2], bfhi(g.y) * v0[3], bflo(g.z) * v1[0], bfhi(g.z) * v1[1], bflo(g.w) * v1[2], bfhi(g.w) * v1[3]};
                    if (SECOND) { const u32x4 t = *(const u32x4*)(MB + off);
                        o[0] += bflo(t.x); o[1] += bfhi(t.x); o[2] += bflo(t.y); o[3] += bfhi(t.y); o[4] += bflo(t.z); o[5] += bfhi(t.z); o[6] += bflo(t.w); o[7] += bfhi(t.w); }
                    u32x4 w; w.x = cvt_pk_bf16(o[0], o[1]); w.y = cvt_pk_bf16(o[2], o[3]); w.z = cvt_pk_bf16(o[4], o[5]); w.w = cvt_pk_bf16(o[6], o[7]);
                    *(u32x4*)(MB + off) = w;
                }
    }
};
}

__constant__ float INV_FREQ[32] = {1.000000000e+00f, 7.498942614e-01f, 5.623413324e-01f, 4.216965139e-01f, 3.162277639e-01f, 2.371373773e-01f, 1.778279394e-01f, 1.333521307e-01f,
    1.000000015e-01f, 7.498941571e-02f, 5.623413250e-02f, 4.216965288e-02f, 3.162277490e-02f, 2.371373773e-02f, 1.778279431e-02f, 1.333521493e-02f,
    9.999999776e-03f, 7.498941850e-03f, 5.623413250e-03f, 4.216964822e-03f, 3.162277630e-03f, 2.371373586e-03f, 1.778279431e-03f, 1.333521446e-03f,
    1.000000047e-03f, 7.498942432e-04f, 5.623413017e-04f, 4.216965172e-04f, 3.162277571e-04f, 2.371373703e-04f, 1.778279402e-04f, 1.333521504e-04f};

__device__ __forceinline__ int dest_row(int mode, int n0) {
    if (mode == 1) { if (n0 < DFF) return 256 * (n0 / 128) + (n0 % 128); const int n1 = n0 - DFF; return 256 * (n1 / 128) + 128 + (n1 % 128); }
    if (mode == 2) { const int tile = n0 >> 8; if (tile >= 8 && tile <= 12) { const int c = n0 & 255, hit = c >> 6, half = (c >> 5) & 1; return (tile << 8) + 128 * half + 32 * hit; } return n0; }
    return n0;
}
__device__ __forceinline__ void transpose_item(const float* W, int K, int N, bf16* WT, int mode, LAS float* scr, int item, int lane) {
    const int nblk = N / 32, kb = item / nblk, nb = item % nblk, k0 = 64 * kb, n0 = 32 * nb;
#pragma unroll 8
    for (int i = 0; i < 32; ++i) { const int kk = 2 * i + (lane >> 5); scr[kk * 33 + (lane & 31)] = W[(size_t)(k0 + kk) * N + n0 + (lane & 31)]; }
    asm volatile("s_waitcnt lgkmcnt(0)" ::: "memory");
    const int c = lane & 7, dr = dest_row(mode, n0);
#pragma unroll
    for (int j = 0; j < 4; ++j) { const int n = (lane >> 3) + 8 * j; const LAS float* s = scr + (8 * c) * 33 + n;
        u32x4 o; o.x = pk2(s[0 * 33], s[1 * 33]); o.y = pk2(s[2 * 33], s[3 * 33]); o.z = pk2(s[4 * 33], s[5 * 33]); o.w = pk2(s[6 * 33], s[7 * 33]);
        *(u32x4*)(WT + (size_t)(dr + n) * K + k0 + 8 * c) = o; }
    asm volatile("s_waitcnt lgkmcnt(0)" ::: "memory");
}
__device__ __forceinline__ void norm_rows(const float* X, const float* g, bf16* XN, int gw, int NGW, int lane) {
    f32x4 gv[4];
#pragma unroll
    for (int j = 0; j < 4; ++j) gv[j] = *((const f32x4*)g + lane + 64 * j);
    for (int m = gw; m < M; m += NGW) {
        const f32x4* xr = (const f32x4*)(X + (size_t)m * D) + lane;
        f32x4 v[4]; float s = 0.f;
#pragma unroll
        for (int j = 0; j < 4; ++j) { v[j] = xr[64 * j]; s += (v[j].x * v[j].x + v[j].y * v[j].y) + (v[j].z * v[j].z + v[j].w * v[j].w); }
        const float r = 1.0f / sqrtf(wave_sum(s) * (1.f / D) + EPS);
        u32x2* o = (u32x2*)(XN + (size_t)m * D) + lane;
#pragma unroll
        for (int j = 0; j < 4; ++j) { u32x2 w; w.x = pk2(v[j].x * r * gv[j].x, v[j].y * r * gv[j].y); w.y = pk2(v[j].z * r * gv[j].z, v[j].w * r * gv[j].w); o[64 * j] = w; }
    }
}
__device__ __forceinline__ void resid_rows(const float* F, const float* base, float* H, bf16* XN, const float* gpost, const float* gnext, float scale, int gw, int NGW, int lane) {
    for (int m = gw; m < M; m += NGW) {
        const f32x4* fr = (const f32x4*)(F + (size_t)m * D) + lane;
        const f32x4* br = (const f32x4*)(base + (size_t)m * D) + lane;
        f32x4 f[4], h[4]; float s = 0.f;
#pragma unroll
        for (int j = 0; j < 4; ++j) { f[j] = fr[64 * j]; h[j] = br[64 * j]; s += (f[j].x * f[j].x + f[j].y * f[j].y) + (f[j].z * f[j].z + f[j].w * f[j].w); }
        const float r = scale / sqrtf(wave_sum(s) * (1.f / D) + EPS);
        float s2 = 0.f;
        f32x4* ho = (f32x4*)(H + (size_t)m * D) + lane;
#pragma unroll
        for (int j = 0; j < 4; ++j) { const f32x4 g = *((const f32x4*)gpost + lane + 64 * j); h[j] = h[j] + f[j] * r * g; ho[64 * j] = h[j];
            s2 += (h[j].x * h[j].x + h[j].y * h[j].y) + (h[j].z * h[j].z + h[j].w * h[j].w); }
        if (XN) {
            const float r2 = 1.0f / sqrtf(wave_sum(s2) * (1.f / D) + EPS);
            u32x2* o = (u32x2*)(XN + (size_t)m * D) + lane;
#pragma unroll
            for (int j = 0; j < 4; ++j) { const f32x4 g = *((const f32x4*)gnext + lane + 64 * j);
                u32x2 w; w.x = pk2(h[j].x * r2 * g.x, h[j].y * r2 * g.y); w.y = pk2(h[j].z * r2 * g.z, h[j].w * r2 * g.w); o[64 * j] = w; }
        }
    }
}
__device__ __forceinline__ void rope_entry(int idx, float* tab) {
    const int pos = idx >> 5, d = idx & 31;
    const float ang = (float)pos * INV_FREQ[d];
    const double x = (double)ang;
    const double k = __builtin_rint(x * 0.63661977236758134308);
    const double r = __builtin_fma(-k, 1.57079632679489661923, x) - k * 6.123233995736766e-17;
    const double r2 = r * r;
    double sp = -1.0 / 39916800.0; sp = sp * r2 + 1.0 / 362880.0; sp = sp * r2 - 1.0 / 5040.0; sp = sp * r2 + 1.0 / 120.0; sp = sp * r2 - 1.0 / 6.0; sp = sp * r2 * r + r;
    double cp = 1.0 / 479001600.0; cp = cp * r2 - 1.0 / 3628800.0; cp = cp * r2 + 1.0 / 40320.0; cp = cp * r2 - 1.0 / 720.0; cp = cp * r2 + 1.0 / 24.0; cp = cp * r2 - 0.5; cp = cp * r2 + 1.0;
    const int q = ((int)k) & 3;
    const double c = (q == 0) ? cp : (q == 1) ? -sp : (q == 2) ? -cp : sp;
    const double s = (q == 0) ? sp : (q == 1) ? cp : (q == 2) ? -sp : -cp;
    tab[2 * idx] = (float)c; tab[2 * idx + 1] = (float)s;
}

constexpr int RL_XS = 0, RL_XC = 33280, RL_A = 70144, RL_B = 102912, RL_SA = 135680, RL_SH = 137728, RL_CARRY = 139776, RL_CW = 140032;
__device__ __forceinline__ void rec_unit(LAS unsigned char* lds, int unit, const bf16* XB, bf16* GB, const float* conv_w, const float* conv_b,
                                         const float* w_a, const float* b_a, const float* w_x, const float* b_x, const float* lam) {
    const int tid = threadIdx.x, lane = tid & 63, wid = tid >> 6, r32 = lane & 31, hi = lane >> 5;
    const int b = unit >> 5, n = (unit >> 1) & 15, half = unit & 1;
    LAS bf16* XS = (LAS bf16*)(lds + RL_XS);
    LAS bf16* XC = (LAS bf16*)(lds + RL_XC);
    LAS float* A32 = (LAS float*)(lds + RL_A);
    LAS float* B32 = (LAS float*)(lds + RL_B);
    LAS float* SA = (LAS float*)(lds + RL_SA);
    LAS float* SH = (LAS float*)(lds + RL_SH);
    LAS float* CARRY = (LAS float*)(lds + RL_CARRY);
    LAS float* CW = (LAS float*)(lds + RL_CW);
    if (tid < 256) CW[tid] = conv_w[(size_t)(tid >> 6) * D + n * 64 + (tid & 63)];
    else if (tid < 320) CW[tid] = conv_b[n * 64 + (tid & 63)];
    if (tid < 32) CARRY[tid] = 0.f;
    const int ch = n * 64 + half * 32 + r32;
    const float ba = b_a[ch], bx = b_x[ch];
    const float sp = log1pf(__expf(-lam[ch]));
    bf16x8 wa[4], wx[4];
#pragma unroll
    for (int ks = 0; ks < 4; ++ks)
#pragma unroll
        for (int j = 0; j < 8; ++j) {
            const size_t wi = ((size_t)n * 64 + 16 * ks + 8 * hi + j) * 64 + half * 32 + r32;
            wa[ks][j] = (short)(pk2(w_a[wi], 0.f) & 0xffffu); wx[ks][j] = (short)(pk2(w_x[wi], 0.f) & 0xffffu);
        }
    const size_t tokbase = (size_t)b * SEQ;
    const bf16* xsrc = XB + n * 64 + 8 * (tid & 7);
    u32x4 pre[5];
#pragma unroll
    for (int it = 0; it < 5; ++it) { const int i = (tid >> 3) + 64 * it, t = i - 3; pre[it] = (u32x4){0u, 0u, 0u, 0u};
        if (i < 259 && t >= 0) pre[it] = *(const u32x4*)(xsrc + (tokbase + t) * D); }
    for (int k = 0; k < SEQ / 256; ++k) {
        const int t0 = 256 * k;
#pragma unroll
        for (int it = 0; it < 5; ++it) { const int i = (tid >> 3) + 64 * it; if (i < 259) *(LAS u32x4*)(XS + i * 64 + 8 * (tid & 7)) = pre[it]; }
        __syncthreads();
        if (k + 1 < SEQ / 256) {
#pragma unroll
            for (int it = 0; it < 5; ++it) { const int i = (tid >> 3) + 64 * it, t = t0 + 256 + i - 3; if (i < 259) pre[it] = *(const u32x4*)(xsrc + (tokbase + t) * D); }
        }
#pragma unroll
        for (int it = 0; it < 4; ++it) {
            const int id = tid + 512 * it, g8 = id & 7, tt = id >> 3;
            float o[8];
            { const f32x4 c0 = *(const LAS f32x4*)(CW + 256 + 8 * g8), c1 = *(const LAS f32x4*)(CW + 256 + 8 * g8 + 4);
              o[0] = c0[0]; o[1] = c0[1]; o[2] = c0[2]; o[3] = c0[3]; o[4] = c1[0]; o[5] = c1[1]; o[6] = c1[2]; o[7] = c1[3]; }
#pragma unroll
            for (int tap = 0; tap < 4; ++tap) {
                const u32x4 xv = *(const LAS u32x4*)(XS + (tt + tap) * 64 + 8 * g8);
                const f32x4 c0 = *(const LAS f32x4*)(CW + 64 * tap + 8 * g8), c1 = *(const LAS f32x4*)(CW + 64 * tap + 8 * g8 + 4);
                o[0] += c0[0] * bflo(xv.x); o[1] += c0[1] * bfhi(xv.x); o[2] += c0[2] * bflo(xv.y); o[3] += c0[3] * bfhi(xv.y);
                o[4] += c1[0] * bflo(xv.z); o[5] += c1[1] * bfhi(xv.z); o[6] += c1[2] * bflo(xv.w); o[7] += c1[3] * bfhi(xv.w);
            }
            u32x4 w; w.x = pk2(o[0], o[1]); w.y = pk2(o[2], o[3]); w.z = pk2(o[4], o[5]); w.w = pk2(o[6], o[7]);
            *(LAS u32x4*)(XC + tt * 72 + 8 * g8) = w;
        }
        __syncthreads();
        f32x16 aa, ax;
#pragma unroll
        for (int i = 0; i < 16; ++i) { aa[i] = 0.f; ax[i] = 0.f; }
#pragma unroll
        for (int ks = 0; ks < 4; ++ks) {
            const bf16x8 af = *(const LAS bf16x8*)(XC + (32 * wid + r32) * 72 + 16 * ks + 8 * hi);
            aa = __builtin_amdgcn_mfma_f32_32x32x16_bf16(af, wa[ks], aa, 0, 0, 0);
            ax = __builtin_amdgcn_mfma_f32_32x32x16_bf16(af, wx[ks], ax, 0, 0, 0);
        }
#pragma unroll
        for (int i = 0; i < 16; ++i) {
            const int tok = 32 * wid + (i & 3) + 8 * (i >> 2) + 4 * hi;
            const float ra = sigmoidf_(aa[i] + ba), ii = sigmoidf_(ax[i] + bx);
            const float la = -8.0f * ra * sp;
            const float a = __expf(la);
            const float mult = sqrtf(fmaxf(-expm1f(2.0f * la), 0.f));
            const float xcv = bf2f(XC[tok * 72 + half * 32 + r32]);
            A32[tok * 32 + r32] = a; B32[tok * 32 + r32] = mult * ii * xcv;
        }
        __syncthreads();
        const int c = tid & 31, seg = tid >> 5;
        bf16* gptr = GB + (tokbase + t0 + 16 * seg) * D + n * 64 + half * 32 + c;
        bf16 gate[16];
#pragma unroll
        for (int j = 0; j < 16; ++j) gate[j] = gptr[(size_t)j * D];
        {
            float Aacc = 1.f, Hh = 0.f;
#pragma unroll
            for (int j = 0; j < 16; ++j) { const float a = A32[(16 * seg + j) * 32 + c], bb = B32[(16 * seg + j) * 32 + c]; Hh = a * Hh + bb; Aacc *= a; }
            SA[seg * 32 + c] = Aacc; SH[seg * 32 + c] = Hh;
        }
        __syncthreads();
        {
            float h = CARRY[(k & 1) * 32 + c];
            for (int s = 0; s < seg; ++s) h = SA[s * 32 + c] * h + SH[s * 32 + c];
#pragma unroll
            for (int j = 0; j < 16; ++j) { const float a = A32[(16 * seg + j) * 32 + c], bb = B32[(16 * seg + j) * 32 + c]; h = a * h + bb;
                gptr[(size_t)j * D] = (bf16)(pk2(h * bf2f(gate[j]), 0.f) & 0xffffu); }
            if (seg == 15) CARRY[((k + 1) & 1) * 32 + c] = h;
        }
    }
    __syncthreads();
}

constexpr int AT_KS = 0, AT_VT = 36864;
__device__ __forceinline__ void attn_unit(LAS unsigned char* lds, int unit, bf16* Q, const bf16* K, const bf16* V, const float* sinks) {
    const int tid = threadIdx.x, lane = tid & 63, wid = tid >> 6, r32 = lane & 31, hi = lane >> 5;
    const int b = unit >> 6, nb = (unit >> 2) & 15, kvh = unit & 3;
    LAS bf16* KS = (LAS bf16*)(lds + AT_KS);
    LAS bf16* VT = (LAS bf16*)(lds + AT_VT);
    const long rowq0 = (long)b * SEQ + nb * 128, rowk0 = rowq0 - 128;
#pragma unroll
    for (int it = 0; it < 4; ++it) {
        const int key = (tid >> 3) + 64 * it, cch = tid & 7;
        u32x4 kv = (u32x4){0u, 0u, 0u, 0u}, vv = (u32x4){0u, 0u, 0u, 0u};
        if (nb > 0 || key >= 128) { kv = *(const u32x4*)(K + (rowk0 + key) * 256 + kvh * 64 + 8 * cch); vv = *(const u32x4*)(V + (rowk0 + key) * 256 + kvh * 64 + 8 * cch); }
        *(LAS u32x4*)(KS + key * 72 + 8 * cch) = kv;
        const int pp = (key & ~15) + 8 * ((key >> 2) & 1) + 4 * ((key >> 3) & 1) + (key & 3);
        LAS bf16* vp = VT + (8 * cch) * 264 + pp;
        vp[0 * 264] = (bf16)(vv.x & 0xffffu); vp[1 * 264] = (bf16)(vv.x >> 16); vp[2 * 264] = (bf16)(vv.y & 0xffffu); vp[3 * 264] = (bf16)(vv.y >> 16);
        vp[4 * 264] = (bf16)(vv.z & 0xffffu); vp[5 * 264] = (bf16)(vv.z >> 16); vp[6 * 264] = (bf16)(vv.w & 0xffffu); vp[7 * 264] = (bf16)(vv.w >> 16);
    }
    const int g = wid >> 1, qh = wid & 1, hq = kvh * 4 + g;
    bf16* qbase = Q + (size_t)(rowq0 + 64 * qh + r32) * D + hq * 64;
    bf16x8 qf[2][4];
#pragma unroll
    for (int qi = 0; qi < 2; ++qi)
#pragma unroll
        for (int ks = 0; ks < 4; ++ks) qf[qi][ks] = *(const bf16x8*)(qbase + (size_t)(32 * qi) * D + 16 * ks + 8 * hi);
    const float sink2 = sinks[hq] * LOG2E;
    __syncthreads();
#pragma unroll
    for (int qi = 0; qi < 2; ++qi) {
        const int kt0 = 2 * qh + qi;
        f32x16 s[5];
#pragma unroll
        for (int j = 0; j < 5; ++j) {
#pragma unroll
            for (int i = 0; i < 16; ++i) s[j][i] = 0.f;
#pragma unroll
            for (int ks = 0; ks < 4; ++ks) {
                const bf16x8 kf = *(const LAS bf16x8*)(KS + (32 * (kt0 + j) + r32) * 72 + 16 * ks + 8 * hi);
                s[j] = __builtin_amdgcn_mfma_f32_32x32x16_bf16(kf, qf[qi][ks], s[j], 0, 0, 0);
            }
        }
        float mx = sink2;
#pragma unroll
        for (int j = 0; j < 5; ++j) {
            const bool tile_ok = (nb > 0) || (kt0 + j >= 4);
#pragma unroll
            for (int i = 0; i < 16; ++i) {
                const int kk = (i & 3) + 8 * (i >> 2) + 4 * hi;
                bool ok = tile_ok;
                if (j == 0) ok = ok && (kk > r32);
                if (j == 4) ok = ok && (kk <= r32);
                s[j][i] = ok ? s[j][i] : -1e30f;
                mx = fmaxf(mx, s[j][i]);
            }
        }
        mx = fmaxf(mx, __shfl_xor(mx, 32));
        float l = 0.f;
#pragma unroll
        for (int j = 0; j < 5; ++j)
#pragma unroll
            for (int i = 0; i < 16; ++i) { const float p = __builtin_amdgcn_exp2f(s[j][i] - mx); s[j][i] = p; l += p; }
        l += __shfl_xor(l, 32);
        l += __builtin_amdgcn_exp2f(sink2 - mx);
        f32x16 o[2];
#pragma unroll
        for (int i = 0; i < 16; ++i) { o[0][i] = 0.f; o[1][i] = 0.f; }
#pragma unroll
        for (int j = 0; j < 5; ++j)
#pragma unroll
            for (int s2 = 0; s2 < 2; ++s2) {
                u32x4 pw; pw.x = pk2(s[j][8 * s2 + 0], s[j][8 * s2 + 1]); pw.y = pk2(s[j][8 * s2 + 2], s[j][8 * s2 + 3]); pw.z = pk2(s[j][8 * s2 + 4], s[j][8 * s2 + 5]); pw.w = pk2(s[j][8 * s2 + 6], s[j][8 * s2 + 7]);
                const bf16x8 pf = __builtin_bit_cast(bf16x8, pw);
#pragma unroll
                for (int db = 0; db < 2; ++db) {
                    const bf16x8 vf = *(const LAS bf16x8*)(VT + (32 * db + r32) * 264 + 32 * (kt0 + j) + 16 * s2 + 8 * hi);
                    o[db] = __builtin_amdgcn_mfma_f32_32x32x16_bf16(vf, pf, o[db], 0, 0, 0);
                }
            }
        const float inv = 1.0f / l;
        bf16* op = qbase + (size_t)(32 * qi) * D;
#pragma unroll
        for (int db = 0; db < 2; ++db)
#pragma unroll
            for (int i4 = 0; i4 < 4; ++i4) {
                u32x2 w; w.x = pk2(o[db][4 * i4 + 0] * inv, o[db][4 * i4 + 1] * inv); w.y = pk2(o[db][4 * i4 + 2] * inv, o[db][4 * i4 + 3] * inv);
                *(u32x2*)(op + 32 * db + 8 * i4 + 4 * hi) = w;
            }
    }
    __syncthreads();
}

struct Args { const float* in[23]; float* out; unsigned char* ws; int ph_lo, ph_hi; };
enum { I_X = 0, I_F1PRE, I_F1GU, I_F1DN, I_F1POST, I_MIXPRE, I_WIN, I_CONVW, I_CONVB, I_WA, I_BA, I_WX, I_BX, I_LAM, I_SINK, I_WPL, I_WPA, I_WOUT, I_MIXPOST, I_F2PRE, I_F2GU, I_F2DN, I_F2POST };

__global__ void __launch_bounds__(NTHREADS, 2) fwd(Args a) {
    extern __shared__ __attribute__((aligned(16))) unsigned char lds_raw[];
    LAS unsigned char* lds = (LAS unsigned char*)lds_raw;
    cg::grid_group grid = cg::this_grid();
    const int tid = threadIdx.x, lane = tid & 63, wave = __builtin_amdgcn_readfirstlane(tid >> 6);
    const int G = gridDim.x, bx = blockIdx.x;
    const int gw = bx * NWAVES + wave, NGW = G * NWAVES;
    unsigned char* ws = a.ws;
    bf16* WGU = (bf16*)(ws + WS_WGU); bf16* WD = (bf16*)(ws + WS_WD); bf16* WIN = (bf16*)(ws + WS_WIN);
    bf16* WPL = (bf16*)(ws + WS_WPL); bf16* WPA = (bf16*)(ws + WS_WPA); bf16* WOUT = (bf16*)(ws + WS_WOUT);
    float* ROPE = (float*)(ws + WS_ROPE);
    bf16* XN = (bf16*)(ws + WS_XN); bf16* ACT = (bf16*)(ws + WS_ACT); float* F = (float*)(ws + WS_F);
    bf16* GB = (bf16*)(ws + WS_GB); bf16* XB = (bf16*)(ws + WS_XB); bf16* Qb = (bf16*)(ws + WS_Q); bf16* Kb = (bf16*)(ws + WS_K); bf16* Vb = (bf16*)(ws + WS_V);
    bf16* GL = (bf16*)(ws + WS_GL); bf16* GA = (bf16*)(ws + WS_GA); bf16* MB = (bf16*)(ws + WS_MB);
    float* H = a.out;
    const int lo = a.ph_lo, hi = a.ph_hi;
#define IN(k) (lo <= (k) && (k) < hi)
#define SEAM(k) do { if (IN(k) && IN((k) + 1)) grid.sync(); } while (0)

    if (IN(0)) {
        LAS float* scr = (LAS float*)(lds + wave * 16384);
        constexpr int I_GU = (D / 64) * (NGU / 32), I_DN = (DFF / 64) * (D / 32), I_IN = (D / 64) * (NIN / 32), I_PR = (D / 64) * (D / 32);
        constexpr int NITEMS = I_GU + I_DN + I_IN + 3 * I_PR;
        for (int it = gw; it < NITEMS; it += NGW) {
            int r = it;
            if (r < I_GU) { transpose_item(a.in[I_F1GU], D, NGU, WGU, 1, scr, r, lane); continue; } r -= I_GU;
            if (r < I_DN) { transpose_item(a.in[I_F1DN], DFF, D, WD, 0, scr, r, lane); continue; } r -= I_DN;
            if (r < I_IN) { transpose_item(a.in[I_WIN], D, NIN, WIN, 2, scr, r, lane); continue; } r -= I_IN;
            if (r < I_PR) { transpose_item(a.in[I_WPL], D, D, WPL, 0, scr, r, lane); continue; } r -= I_PR;
            if (r < I_PR) { transpose_item(a.in[I_WPA], D, D, WPA, 0, scr, r, lane); continue; } r -= I_PR;
            transpose_item(a.in[I_WOUT], D, D, WOUT, 0, scr, r, lane);
        }
        for (int i = bx * NTHREADS + tid; i < SEQ * 32; i += G * NTHREADS) rope_entry(i, ROPE);
        norm_rows(a.in[I_X], a.in[I_F1PRE], XN, gw, NGW, lane);
    }
    SEAM(0);
    if (IN(1)) {
        __syncthreads();
        pg8::Gemm g{XN, WGU, M, NGU, D}; pg8::StaticOrder S; S.init(M, NGU, G, bx);
        pg8::EpiSwiglu E{ACT};
        pg8::gemm_phase<pg8::EpiSwiglu, pg8::StaticOrder, true, true>(lds, g, S, E);
    }
    SEAM(1);
    if (IN(2)) {
        pg8::Gemm g{ACT, WD, M, D, DFF}; pg8::StaticOrder S; S.init(M, D, G, bx);
        pg8::EpiF32 E{F, D};
        pg8::gemm_phase<pg8::EpiF32, pg8::StaticOrder, true, true>(lds, g, S, E);
    }
    SEAM(2);
    if (IN(3)) {
        LAS float* scr = (LAS float*)(lds + wave * 16384);
        constexpr int I_GU = (D / 64) * (NGU / 32), I_DN = (DFF / 64) * (D / 32);
        for (int it = gw; it < I_GU + I_DN; it += NGW) {
            if (it < I_GU) transpose_item(a.in[I_F2GU], D, NGU, WGU, 1, scr, it, lane);
            else transpose_item(a.in[I_F2DN], DFF, D, WD, 0, scr, it - I_GU, lane);
        }
        resid_rows(F, a.in[I_X], H, XN, a.in[I_F1POST], a.in[I_MIXPRE], 0.5f, gw, NGW, lane);
    }
    SEAM(3);
    if (IN(4)) {
        __syncthreads();
        pg8::Gemm g{XN, WIN, M, NIN, D}; pg8::StaticOrder S; S.init(M, NIN, G, bx);
        pg8::EpiMix E{GB, XB, Qb, Kb, Vb, GL, GA, ROPE};
        pg8::gemm_phase<pg8::EpiMix, pg8::StaticOrder, true, true>(lds, g, S, E);
    }
    SEAM(4);
    if (IN(5)) {
        for (int u = bx; u < BATCH * 16 * 2; u += G)
            rec_unit(lds, u, XB, GB, a.in[I_CONVW], a.in[I_CONVB], a.in[I_WA], a.in[I_BA], a.in[I_WX], a.in[I_BX], a.in[I_LAM]);
        for (int u = bx; u < BATCH * 16 * 4; u += G)
            attn_unit(lds, u, Qb, Kb, Vb, a.in[I_SINK]);
    }
    SEAM(5);
    if (IN(6)) {
        { pg8::Gemm g{GB, WPL, M, D, D}; pg8::StaticOrder S; S.init(M, D, G, bx);
          pg8::EpiGate<false> E{GL, MB};
          pg8::gemm_phase<pg8::EpiGate<false>, pg8::StaticOrder, true, true>(lds, g, S, E); }
        __syncthreads();
        { pg8::Gemm g{Qb, WPA, M, D, D}; pg8::StaticOrder S; S.init(M, D, G, bx);
          pg8::EpiGate<true> E{GA, MB};
          pg8::gemm_phase<pg8::EpiGate<true>, pg8::StaticOrder, true, true>(lds, g, S, E); }
    }
    SEAM(6);
    if (IN(7)) {
        pg8::Gemm g{MB, WOUT, M, D, D}; pg8::StaticOrder S; S.init(M, D, G, bx);
        pg8::EpiF32 E{F, D};
        pg8::gemm_phase<pg8::EpiF32, pg8::StaticOrder, true, true>(lds, g, S, E);
    }
    SEAM(7);
    if (IN(8)) resid_rows(F, H, H, XN, a.in[I_MIXPOST], a.in[I_F2PRE], 1.0f, gw, NGW, lane);
    SEAM(8);
    if (IN(9)) {
        pg8::Gemm g{XN, WGU, M, NGU, D}; pg8::StaticOrder S; S.init(M, NGU, G, bx);
        pg8::EpiSwiglu E{ACT};
        pg8::gemm_phase<pg8::EpiSwiglu, pg8::StaticOrder, true, true>(lds, g, S, E);
    }
    SEAM(9);
    if (IN(10)) {
        pg8::Gemm g{ACT, WD, M, D, DFF}; pg8::StaticOrder S; S.init(M, D, G, bx);
        pg8::EpiF32 E{F, D};
        pg8::gemm_phase<pg8::EpiF32, pg8::StaticOrder, true, true>(lds, g, S, E);
    }
    SEAM(10);
    if (IN(11)) resid_rows(F, H, H, nullptr, a.in[I_F2POST], nullptr, 0.5f, gw, NGW, lane);
#undef IN
#undef SEAM
}

#ifndef MK_PER_PHASE
#define MK_PER_PHASE 0
#endif
extern "C" void kernel_launch(void* const* d_in, const int* in_sizes, int n_in, void* d_out, int out_size, void* d_ws, size_t ws_size, hipStream_t stream) {
    static int grid = 0;
    if (grid == 0) {
        if (n_in != 23 || out_size != M * D || ws_size < WS_END) { fprintf(stderr, "kernel_launch: unexpected shapes (n_in %d out %d ws %zu)\n", n_in, out_size, ws_size); grid = -1; return; }
        int dev = 0, cus = 0, per_cu = 0;
        if (hipGetDevice(&dev) != hipSuccess || hipDeviceGetAttribute(&cus, hipDeviceAttributeMultiprocessorCount, dev) != hipSuccess) { grid = -1; return; }
        if (hipFuncSetAttribute((const void*)fwd, hipFuncAttributeMaxDynamicSharedMemorySize, LDS_BYTES) != hipSuccess) { fprintf(stderr, "kernel_launch: hipFuncSetAttribute failed\n"); grid = -1; return; }
        if (hipOccupancyMaxActiveBlocksPerMultiprocessor(&per_cu, (const void*)fwd, NTHREADS, LDS_BYTES) != hipSuccess || per_cu < 1) per_cu = 1;
        (void)hipGetLastError();
        grid = cus * per_cu;
        fprintf(stderr, "kernel_launch: grid %d (cus %d x %d), ws %zu\n", grid, cus, per_cu, ws_size);
    }
    if (grid < 0) return;
    Args a{};
    for (int i = 0; i < 23; ++i) a.in[i] = (const float*)d_in[i];
    a.out = (float*)d_out; a.ws = (unsigned char*)d_ws;
#if MK_PER_PHASE
    for (int p = 0; p < 12; ++p) { a.ph_lo = p; a.ph_hi = p + 1; hipLaunchKernelGGL(fwd, dim3(grid), dim3(NTHREADS), LDS_BYTES, stream, a); }
#else
    a.ph_lo = 0; a.ph_hi = 12;
    void* args[] = {&a};
    hipError_t e = hipLaunchCooperativeKernel((const void*)fwd, dim3(grid), dim3(NTHREADS), args, LDS_BYTES, stream);
    if (e != hipSuccess) fprintf(stderr, "kernel_launch: cooperative launch failed: %s (grid %d)\n", hipGetErrorString(e), grid);
#endif
}
```

```cpp
#include <hip/hip_runtime.h>
#include <hip/hip_cooperative_groups.h>
#include <cstdio>
#include <cstdint>
namespace cg = cooperative_groups;
namespace pg8 {
#define PG8_LAS __attribute__((address_space(3)))
typedef unsigned short bf16_t;
typedef short bf16x8 __attribute__((ext_vector_type(8)));
typedef float f32x4 __attribute__((ext_vector_type(4)));
typedef unsigned u32x4 __attribute__((ext_vector_type(4)));
constexpr int BM = 256, BK = 64, HALF = 128, HTB = HALF * BK * 2  , STAGE_BYTES = 8 * HTB, NXCD = 8, WGM = 8;

__host__ __device__ __forceinline__ int lds_byte(int r, int c) { const int st = (r >> 4) * 2 + (c >> 5), rr = r & 15, cc = c & 31, ob = rr * 64 + cc * 2; return st * 1024 + (ob ^ (((ob >> 9) & 1) << 5)); }
__host__ __device__ __forceinline__ void stage_rc(int b, int& R, int& C) { const int st = b / 1024, sb = b % 1024, swz = sb ^ (((sb >> 9) & 1) << 5); R = (st >> 1) * 16 + swz / 64; C = (st & 1) * 32 + (swz % 64) / 2; }
__host__ __device__ __forceinline__ int perm32(int rho) { const int n = rho >> 4, i = rho & 15; return 8 * (i >> 2) + 4 * n + (i & 3); }

struct Unit { int pm, pn; };
struct Gemm { const bf16_t* A; const bf16_t* Bt; int M, N, K; };

struct StaticOrder {
    int nM, nN, nwg, G, c;
    __host__ __device__ void init(int M, int N, int G_, int c_) { nM = M / BM; nN = N / BM; nwg = nM * nN; G = G_; c = c_; }
    __host__ __device__ bool next(int i, Unit& u) const {
        const long L = (long)i * G + c; if (L >= nwg) return false;
        int wgid = (int)L; { const int q = nwg / NXCD, r = nwg % NXCD, xcd = wgid % NXCD, off = wgid / NXCD; wgid = (xcd < r ? xcd * (q + 1) : r * (q + 1) + (xcd - r) * q) + off; }
        const int nig = WGM * nN, gid = wgid / nig, fm = gid * WGM, gsz = (nM - fm) < WGM ? (nM - fm) : WGM;
        u.pm = fm + ((wgid % nig) % gsz); u.pn = (wgid % nig) / gsz; return true;
    }
    __device__ __forceinline__ void a_ready(const Unit&) const {}
    __device__ __forceinline__ void done(const Unit&) const {}
};

__device__ __forceinline__ unsigned cvt_pk_bf16(float lo, float hi) { unsigned r; asm volatile("v_cvt_pk_bf16_f32 %0, %1, %2" : "=v"(r) : "v"(lo), "v"(hi)); return r; }
typedef float f32x2 __attribute__((ext_vector_type(2)));
template <class Epi, class Sched, bool ALIGN_EPI = false, bool SP2 = false>
__device__ __forceinline__ void gemm_phase(PG8_LAS unsigned char* lds, const Gemm g, const Sched& S, const Epi& E) {
    const int tid = threadIdx.x, wid = __builtin_amdgcn_readfirstlane(tid >> 6), lane = tid & 63, wr = wid >> 2, wc = wid & 3, fr = lane & 15, fq = lane >> 4;
    const int K = g.K, nt = K / BK;
    unsigned voffA[2], voffB[2];
#pragma unroll
    for (int i = 0; i < 2; ++i) { int R, C; stage_rc(tid * 16 + i * 8192, R, C); const int Rb = Epi::PERM ? ((R & ~31) + perm32(R & 31)) : R;
        voffA[i] = (unsigned)(R * K + C) * 2u; voffB[i] = (unsigned)(Rb * K + C) * 2u; }
    const size_t kstep = (size_t)(BK * 2);
    const size_t hstep = (size_t)HALF * K * 2;
    const size_t tstep = 2 * hstep;
    const unsigned ldsw = (unsigned)wid * 1024u;
    const int aoff = lds_byte(wr * 64 + fr, fq * 8), boff = lds_byte(wc * 32 + fr, fq * 8);
#define PG8_SA(b, h) (((b) * 2 + (h)) * HTB)
#define PG8_SB(b, h) ((4 + (b) * 2 + (h)) * HTB)
#define PG8_STAGE(bufoff, gbase, voff) do { _Pragma("unroll") for (int _i = 0; _i < 2; ++_i) \
        __builtin_amdgcn_global_load_lds((const unsigned*)((const char*)(gbase) + (voff)[_i]), (PG8_LAS unsigned*)(lds + (bufoff) + ldsw + _i * 8192), 16, 0, 0); } while (0)
#define PG8_LDA(dst, b, h) do { _Pragma("unroll") for (int m = 0; m < 4; ++m) _Pragma("unroll") for (int k = 0; k < 2; ++k) dst[m][k] = *(const PG8_LAS bf16x8*)(lds + PG8_SA(b, h) + aoff + m * 2048 + k * 1024); } while (0)
#define PG8_LDB(dst, b, h) do { _Pragma("unroll") for (int n = 0; n < 2; ++n) _Pragma("unroll") for (int k = 0; k < 2; ++k) dst[n][k] = *(const PG8_LAS bf16x8*)(lds + PG8_SB(b, h) + boff + n * 2048 + k * 1024); } while (0)
#define PG8_MMA(ai, bj, At, Bt) do { __builtin_amdgcn_s_setprio(1); _Pragma("unroll") for (int m = 0; m < 4; ++m) _Pragma("unroll") for (int n = 0; n < 2; ++n) _Pragma("unroll") for (int k = 0; k < 2; ++k) \
        acc[ai][bj][m][n] = __builtin_amdgcn_mfma_f32_16x16x32_bf16(Bt[n][k], At[m][k], acc[ai][bj][m][n], 0, 0, 0); __builtin_amdgcn_s_setprio(0); } while (0)
#define PG8_WAIT_V(n) asm volatile("s_waitcnt vmcnt(" #n ")" ::: "memory")
#define PG8_WAIT_L(n) asm volatile("s_waitcnt lgkmcnt(" #n ")" ::: "memory")
#define PG8_BAR __builtin_amdgcn_s_barrier()
#define PG8_SCHED __builtin_amdgcn_sched_barrier(0)
    Unit cur, nxt; int ui = 0;
    if (!S.next(0, cur)) return;
    f32x4 acc[2][2][4][2];
#pragma unroll
    for (int a = 0; a < 2; ++a)
#pragma unroll
        for (int b = 0; b < 2; ++b)
#pragma unroll
            for (int m = 0; m < 4; ++m)
#pragma unroll
                for (int n = 0; n < 2; ++n) acc[a][b][m][n] = (f32x4){0.f, 0.f, 0.f, 0.f};
    bf16x8 At[4][2], B0[2][2], B1[2][2];
    const char* cA = (const char*)g.A + (size_t)cur.pm * tstep; const char* cB = (const char*)g.Bt + (size_t)cur.pn * tstep;
    S.a_ready(cur);
    if constexpr (SP2) {
        PG8_STAGE(PG8_SB(0, 0), cB, voffB); PG8_STAGE(PG8_SB(0, 1), cB + hstep, voffB); PG8_STAGE(PG8_SA(0, 0), cA, voffA); PG8_STAGE(PG8_SA(0, 1), cA + hstep, voffA);
        if (wr == 1) PG8_BAR;
        PG8_WAIT_V(2); PG8_BAR;
        PG8_STAGE(PG8_SB(1, 0), cB + kstep, voffB); PG8_STAGE(PG8_SA(1, 0), cA + kstep, voffA); PG8_STAGE(PG8_SB(1, 1), cB + hstep + kstep, voffB);
        PG8_WAIT_V(6); PG8_BAR;
    } else {
        PG8_STAGE(PG8_SB(0, 0), cB, voffB); PG8_STAGE(PG8_SA(0, 0), cA, voffA); PG8_STAGE(PG8_SB(0, 1), cB + hstep, voffB); PG8_STAGE(PG8_SA(0, 1), cA + hstep, voffA);
        if (wr == 1) PG8_BAR;
        PG8_WAIT_V(4); PG8_BAR;
        PG8_STAGE(PG8_SB(1, 0), cB + kstep, voffB); PG8_STAGE(PG8_SA(1, 0), cA + kstep, voffA); PG8_STAGE(PG8_SB(1, 1), cB + hstep + kstep, voffB);
        PG8_WAIT_V(6); PG8_BAR;
    }
    for (;;) {
        const bool has_next = S.next(ui + 1, nxt);
        const char* nA = has_next ? (const char*)g.A + (size_t)nxt.pm * tstep : cA; const char* nB = has_next ? (const char*)g.Bt + (size_t)nxt.pn * tstep : cB;
        for (int t = 0; t < nt; t += 2) {
            const bool last = (t == nt - 2);
            const char* a1 = cA + (size_t)(t + 1) * kstep;
            const char* a2 = last ? nA : cA + (size_t)(t + 2) * kstep; const char* b2 = last ? nB : cB + (size_t)(t + 2) * kstep;
            const char* a3 = a2 + kstep; const char* b3 = b2 + kstep;
            if (last && has_next) S.a_ready(nxt);
            if constexpr (SP2) {
            PG8_LDB(B0, 0, 0); PG8_LDB(B1, 0, 1); PG8_SCHED; PG8_LDA(At, 0, 0); PG8_STAGE(PG8_SA(1, 1), a1 + hstep, voffA);
            PG8_WAIT_V(8); PG8_WAIT_L(0); PG8_BAR; PG8_MMA(0, 0, At, B0); PG8_MMA(0, 1, At, B1); PG8_BAR; PG8_SCHED;
            PG8_LDA(At, 0, 1); PG8_STAGE(PG8_SB(0, 0), b2, voffB); PG8_STAGE(PG8_SB(0, 1), b2 + hstep, voffB); PG8_STAGE(PG8_SA(0, 0), a2, voffA);
            PG8_WAIT_V(8); PG8_WAIT_L(0); PG8_BAR; PG8_MMA(1, 0, At, B0); PG8_MMA(1, 1, At, B1); PG8_BAR; PG8_SCHED;
            PG8_LDB(B0, 1, 0); PG8_LDB(B1, 1, 1); PG8_SCHED; PG8_LDA(At, 1, 0); PG8_STAGE(PG8_SA(0, 1), a2 + hstep, voffA);
            PG8_WAIT_V(8); PG8_WAIT_L(0); PG8_BAR; PG8_MMA(0, 0, At, B0); PG8_MMA(0, 1, At, B1); PG8_BAR; PG8_SCHED;
            PG8_LDA(At, 1, 1); PG8_STAGE(PG8_SB(1, 0), b3, voffB); PG8_STAGE(PG8_SB(1, 1), b3 + hstep, voffB); PG8_STAGE(PG8_SA(1, 0), a3, voffA);
            PG8_WAIT_V(8); PG8_WAIT_L(0); PG8_BAR; PG8_MMA(1, 0, At, B0); PG8_MMA(1, 1, At, B1); PG8_BAR; PG8_SCHED;
            } else {
            PG8_LDB(B0, 0, 0); PG8_SCHED; PG8_LDA(At, 0, 0); PG8_STAGE(PG8_SA(1, 1), a1 + hstep, voffA);
            PG8_WAIT_L(8); PG8_BAR; PG8_WAIT_L(0); PG8_MMA(0, 0, At, B0); PG8_BAR; PG8_SCHED;
            PG8_LDB(B1, 0, 1); PG8_STAGE(PG8_SB(0, 0), b2, voffB);
            PG8_BAR; PG8_WAIT_L(0); PG8_MMA(0, 1, At, B1); PG8_BAR;
            PG8_LDA(At, 0, 1); PG8_STAGE(PG8_SA(0, 0), a2, voffA);
            PG8_BAR; PG8_WAIT_L(0); PG8_MMA(1, 0, At, B0); PG8_BAR; PG8_SCHED;
            PG8_STAGE(PG8_SB(0, 1), b2 + hstep, voffB);
            PG8_WAIT_V(6); PG8_BAR; PG8_MMA(1, 1, At, B1); PG8_BAR;
            PG8_LDB(B0, 1, 0); PG8_SCHED; PG8_LDA(At, 1, 0); PG8_STAGE(PG8_SA(0, 1), a2 + hstep, voffA);
            PG8_WAIT_L(8); PG8_BAR; PG8_WAIT_L(0); PG8_MMA(0, 0, At, B0); PG8_BAR; PG8_SCHED;
            PG8_LDB(B1, 1, 1); PG8_STAGE(PG8_SB(1, 0), b3, voffB);
            PG8_BAR; PG8_WAIT_L(0); PG8_MMA(0, 1, At, B1); PG8_BAR;
            PG8_LDA(At, 1, 1); PG8_STAGE(PG8_SA(1, 0), a3, voffA);
            PG8_BAR; PG8_WAIT_L(0); PG8_MMA(1, 0, At, B0); PG8_BAR; PG8_SCHED;
            PG8_STAGE(PG8_SB(1, 1), b3 + hstep, voffB);
            PG8_WAIT_V(6); PG8_BAR; PG8_MMA(1, 1, At, B1); PG8_BAR;
            }
        }
        if constexpr (ALIGN_EPI) { if (wr == 0) PG8_BAR; }
        if constexpr (!Epi::AFTER_DRAIN) { E(acc, cur, wr, wc, fr, fq); S.done(cur); }
        if (!has_next) break;
#pragma unroll
        for (int a = 0; a < 2; ++a)
#pragma unroll
            for (int b = 0; b < 2; ++b)
#pragma unroll
                for (int m = 0; m < 4; ++m)
#pragma unroll
                    for (int n = 0; n < 2; ++n) acc[a][b][m][n] = (f32x4){0.f, 0.f, 0.f, 0.f};
        cur = nxt; cA = nA; cB = nB; ++ui;
        if constexpr (ALIGN_EPI) { if (wr == 1) PG8_BAR; }
    }
    PG8_WAIT_V(0);
    if constexpr (!ALIGN_EPI) { if (wr == 0) PG8_BAR; }
    PG8_BAR;
    if constexpr (Epi::AFTER_DRAIN) { E.fused(acc, cur, wr, wc, fr, fq, lds, wid, lane); S.done(cur); }
#undef PG8_SA
#undef PG8_SB
#undef PG8_STAGE
#undef PG8_LDA
#undef PG8_LDB
#undef PG8_MMA
#undef PG8_WAIT_V
#undef PG8_WAIT_L
#undef PG8_BAR
#undef PG8_SCHED
}
}

constexpr int BATCH = 8, SEQ = 2048, D = 1024, M = BATCH * SEQ, DFF = 2816, NGU = 2 * DFF, NIN = 5632;
constexpr float EPS = 1e-6f, LOG2E = 1.4426950408889634f;
constexpr float QSCALE = 0.125f * LOG2E;
constexpr int NWAVES = 8, NTHREADS = 512;
constexpr int LDS_BYTES = 147456;

constexpr size_t MiB = 1u << 20;
constexpr size_t WS_WGU = 0, WS_WD = 11 * MiB, WS_WIN = 17 * MiB, WS_WPL = 28 * MiB, WS_WPA = 30 * MiB, WS_WOUT = 32 * MiB, WS_ROPE = 34 * MiB;
constexpr size_t WS_XN = 36 * MiB;
constexpr size_t WS_GB = 68 * MiB, WS_XB = 100 * MiB, WS_Q = 132 * MiB, WS_K = 164 * MiB, WS_V = 172 * MiB, WS_GL = 180 * MiB, WS_GA = 212 * MiB;
constexpr size_t WS_ACT = 68 * MiB;
constexpr size_t WS_F = 180 * MiB;
constexpr size_t WS_MB = WS_XB;
constexpr size_t WS_END = 244 * MiB;

#define LAS __attribute__((address_space(3)))
typedef unsigned short bf16;
typedef unsigned u32x4 __attribute__((ext_vector_type(4)));
typedef unsigned u32x2 __attribute__((ext_vector_type(2)));
typedef float f32x4 __attribute__((ext_vector_type(4)));
typedef float f32x2 __attribute__((ext_vector_type(2)));
typedef float f32x16 __attribute__((ext_vector_type(16)));
typedef short bf16x8 __attribute__((ext_vector_type(8)));

__device__ __forceinline__ unsigned pk2(float lo, float hi) { return pg8::cvt_pk_bf16(lo, hi); }
__device__ __forceinline__ float bflo(unsigned w) { return __uint_as_float(w << 16); }
__device__ __forceinline__ float bfhi(unsigned w) { return __uint_as_float(w & 0xffff0000u); }
__device__ __forceinline__ float bf2f(bf16 v) { return __uint_as_float((unsigned)v << 16); }
__device__ __forceinline__ float sigmoidf_(float x) { return __builtin_amdgcn_rcpf(1.f + __builtin_amdgcn_exp2f(-x * LOG2E)); }
__device__ __forceinline__ float siluf_(float x) { return x * sigmoidf_(x); }
__device__ __forceinline__ float gelu_tanh_(float x) { const float y = 0.7978845608028654f * (x + 0.044715f * x * x * x); return x * sigmoidf_(2.f * y); }
__device__ __forceinline__ float act_(float v, int act) { return act == 1 ? gelu_tanh_(v) : (act == 2 ? sigmoidf_(v) : v); }
__device__ __forceinline__ float wave_sum(float v) {
#pragma unroll
    for (int o = 1; o < 64; o <<= 1) v += __shfl_xor(v, o);
    return v;
}

namespace pg8 {
struct EpiSwiglu {
    static constexpr bool PERM = true, AFTER_DRAIN = false;
    bf16_t* O;
    __device__ __forceinline__ void operator()(const f32x4 (&acc)[2][2][4][2], const Unit& u, int wr, int wc, int fr, int fq) const {
        const int row0 = u.pm * BM + wr * 64 + fr, col0 = u.pn * 128 + wc * 32 + 8 * fq;
#pragma unroll
        for (int ai = 0; ai < 2; ++ai)
#pragma unroll
            for (int m = 0; m < 4; ++m) {
                bf16_t* p = O + (size_t)(row0 + ai * HALF + m * 16) * DFF + col0;
                const f32x4 g0 = acc[ai][0][m][0], g1 = acc[ai][0][m][1], u0 = acc[ai][1][m][0], u1 = acc[ai][1][m][1];
                u32x4 w;
                w.x = cvt_pk_bf16(siluf_(g0[0]) * u0[0], siluf_(g0[1]) * u0[1]); w.y = cvt_pk_bf16(siluf_(g0[2]) * u0[2], siluf_(g0[3]) * u0[3]);
                w.z = cvt_pk_bf16(siluf_(g1[0]) * u1[0], siluf_(g1[1]) * u1[1]); w.w = cvt_pk_bf16(siluf_(g1[2]) * u1[2], siluf_(g1[3]) * u1[3]);
                *(u32x4*)p = w;
            }
    }
};
struct EpiF32 {
    static constexpr bool PERM = false, AFTER_DRAIN = false;
    float* O; int ldc;
    __device__ __forceinline__ void operator()(const f32x4 (&acc)[2][2][4][2], const Unit& u, int wr, int wc, int fr, int fq) const {
        const int row0 = u.pm * BM + wr * 64 + fr, col0 = u.pn * BM + wc * 32 + 4 * fq;
#pragma unroll
        for (int ai = 0; ai < 2; ++ai)
#pragma unroll
            for (int m = 0; m < 4; ++m) {
                float* p = O + (size_t)(row0 + ai * HALF + m * 16) * ldc + col0;
#pragma unroll
                for (int bj = 0; bj < 2; ++bj)
#pragma unroll
                    for (int n = 0; n < 2; ++n) *(f32x4*)(p + bj * HALF + n * 16) = acc[ai][bj][m][n];
            }
    }
};
struct EpiMix {
    static constexpr bool PERM = true, AFTER_DRAIN = false;
    bf16_t *GB, *XB, *Q, *K, *V, *GL, *GA; const float* rope;
    __device__ __forceinline__ void operator()(const f32x4 (&acc)[2][2][4][2], const Unit& u, int wr, int wc, int fr, int fq) const {
        const int pn = u.pn, row0 = u.pm * BM + wr * 64 + fr;
        if (pn >= 8 && pn <= 12) {
            const bool isq = pn < 12; bf16_t* base = isq ? Q + 256 * (pn - 8) : K; const int ld = isq ? D : 256; const float sc = isq ? QSCALE : 1.f;
            const int dd0 = 8 * fq, col = 64 * wc + dd0;
#pragma unroll
            for (int ai = 0; ai < 2; ++ai)
#pragma unroll
                for (int m = 0; m < 4; ++m) {
                    const int row = row0 + ai * HALF + m * 16, pos = row & (SEQ - 1);
                    const f32x4* tp = (const f32x4*)(rope + (size_t)(pos * 32 + dd0) * 2);
                    const f32x4 t0 = tp[0], t1 = tp[1], t2 = tp[2], t3 = tp[3];
                    const f32x4 xa = acc[ai][0][m][0], xb = acc[ai][0][m][1], ya = acc[ai][1][m][0], yb = acc[ai][1][m][1];
                    float c[8] = {t0[0], t0[2], t1[0], t1[2], t2[0], t2[2], t3[0], t3[2]};
                    float s[8] = {t0[1], t0[3], t1[1], t1[3], t2[1], t2[3], t3[1], t3[3]};
                    float x1[8] = {xa[0], xa[1], xa[2], xa[3], xb[0], xb[1], xb[2], xb[3]};
                    float x2[8] = {ya[0], ya[1], ya[2], ya[3], yb[0], yb[1], yb[2], yb[3]};
                    float o1[8], o2[8];
#pragma unroll
                    for (int j = 0; j < 8; ++j) { o1[j] = (x1[j] * c[j] - x2[j] * s[j]) * sc; o2[j] = (x2[j] * c[j] + x1[j] * s[j]) * sc; }
                    u32x4 w1, w2;
                    w1.x = cvt_pk_bf16(o1[0], o1[1]); w1.y = cvt_pk_bf16(o1[2], o1[3]); w1.z = cvt_pk_bf16(o1[4], o1[5]); w1.w = cvt_pk_bf16(o1[6], o1[7]);
                    w2.x = cvt_pk_bf16(o2[0], o2[1]); w2.y = cvt_pk_bf16(o2[2], o2[3]); w2.z = cvt_pk_bf16(o2[4], o2[5]); w2.w = cvt_pk_bf16(o2[6], o2[7]);
                    bf16_t* p = base + (size_t)row * ld + col;
                    *(u32x4*)p = w1; *(u32x4*)(p + 32) = w2;
                }
        } else {
            bf16_t* base; int ld = D, act = 0;
            if (pn < 4) { base = GB + 256 * pn; act = 1; }
            else if (pn < 8) { base = XB + 256 * (pn - 4); }
            else if (pn == 13) { base = V; ld = 256; }
            else if (pn < 18) { base = GL + 256 * (pn - 14); act = 2; }
            else { base = GA + 256 * (pn - 18); act = 2; }
            const int col0 = wc * 32 + 8 * fq;
#pragma unroll
            for (int ai = 0; ai < 2; ++ai)
#pragma unroll
                for (int m = 0; m < 4; ++m) {
                    bf16_t* p = base + (size_t)(row0 + ai * HALF + m * 16) * ld + col0;
#pragma unroll
                    for (int bj = 0; bj < 2; ++bj) {
                        const f32x4 v0 = acc[ai][bj][m][0], v1 = acc[ai][bj][m][1];
                        u32x4 w;
                        w.x = cvt_pk_bf16(act_(v0[0], act), act_(v0[1], act)); w.y = cvt_pk_bf16(act_(v0[2], act), act_(v0[3], act));
                        w.z = cvt_pk_bf16(act_(v1[0], act), act_(v1[1], act)); w.w = cvt_pk_bf16(act_(v1[2], act), act_(v1[3], act));
                        *(u32x4*)(p + bj * HALF) = w;
                    }
                }
        }
    }
};
template <bool SECOND> struct EpiGate {
    static constexpr bool PERM = true, AFTER_DRAIN = false;
    const bf16_t* G; bf16_t* MB;
    __device__ __forceinline__ void operator()(const f32x4 (&acc)[2][2][4][2], const Unit& u, int wr, int wc, int fr, int fq) const {
        const int row0 = u.pm * BM + wr * 64 + fr, col0 = u.pn * BM + wc * 32 + 8 * fq;
#pragma unroll
        for (int ai = 0; ai < 2; ++ai)
#pragma unroll
            for (int m = 0; m < 4; ++m)
#pragma unroll
                for (int bj = 0; bj < 2; ++bj) {
                    const size_t off = (size_t)(row0 + ai * HALF + m * 16) * D + col0 + bj * HALF;
                    const u32x4 g = *(const u32x4*)(G + off);
                    const f32x4 v0 = acc[ai][bj][m][0], v1 = acc[ai][bj][m][1];
                    float o[8] = {bflo(g.x) * v0[0], bfhi(g.x) * v0[1], bflo(g.y) * v0[2], bfhi(g.y) * v0[3], bflo(g.z) * v1[0], bfhi(g.z) * v1[1], bflo(g.w) * v1[2], bfhi(g.w) * v1[3]};
                    if (SECOND) { const u32x4 t = *(const u32x4*)(MB + off);
                        o[0] += bflo(t.x); o[1] += bfhi(t.x); o[2] += bflo(t.y); o[3] += bfhi(t.y); o[4] += bflo(t.z); o[5] += bfhi(t.z); o[6] += bflo(t.w); o[7] += bfhi(t.w); }
                    u32x4 w; w.x = cvt_pk_bf16(o[0], o[1]); w.y = cvt_pk_bf16(o[2], o[3]); w.z = cvt_pk_bf16(o[4], o[5]); w.w = cvt_pk_bf16(o[6], o[7]);
                    *(u32x4*)(MB + off) = w;
                }
    }
};
}

__constant__ float INV_FREQ[32] = {1.000000000e+00f, 7.498942614e-01f, 5.623413324e-01f, 4.216965139e-01f, 3.162277639e-01f, 2.371373773e-01f, 1.778279394e-01f, 1.333521307e-01f,
    1.000000015e-01f, 7.498941571e-02f, 5.623413250e-02f, 4.216965288e-02f, 3.162277490e-02f, 2.371373773e-02f, 1.778279431e-02f, 1.333521493e-02f,
    9.999999776e-03f, 7.498941850e-03f, 5.623413250e-03f, 4.216964822e-03f, 3.162277630e-03f, 2.371373586e-03f, 1.778279431e-03f, 1.333521446e-03f,
    1.000000047e-03f, 7.498942432e-04f, 5.623413017e-04f, 4.216965172e-04f, 3.162277571e-04f, 2.371373703e-04f, 1.778279402e-04f, 1.333521504e-04f};

__device__ __forceinline__ int dest_row(int mode, int n0) {
    if (mode == 1) { if (n0 < DFF) return 256 * (n0 / 128) + (n0 % 128); const int n1 = n0 - DFF; return 256 * (n1 / 128) + 128 + (n1 % 128); }
    if (mode == 2) { const int tile = n0 >> 8; if (tile >= 8 && tile <= 12) { const int c = n0 & 255, hit = c >> 6, half = (c >> 5) & 1; return (tile << 8) + 128 * half + 32 * hit; } return n0; }
    return n0;
}
__device__ __forceinline__ void transpose_item(const float* W, int K, int N, bf16* WT, int mode, LAS float* scr, int item, int lane) {
    const int nblk = N / 32, kb = item / nblk, nb = item % nblk, k0 = 64 * kb, n0 = 32 * nb;
#pragma unroll 8
    for (int i = 0; i < 32; ++i) { const int kk = 2 * i + (lane >> 5); scr[kk * 33 + (lane & 31)] = W[(size_t)(k0 + kk) * N + n0 + (lane & 31)]; }
    asm volatile("s_waitcnt lgkmcnt(0)" ::: "memory");
    const int c = lane & 7, dr = dest_row(mode, n0);
#pragma unroll
    for (int j = 0; j < 4; ++j) { const int n = (lane >> 3) + 8 * j; const LAS float* s = scr + (8 * c) * 33 + n;
        u32x4 o; o.x = pk2(s[0 * 33], s[1 * 33]); o.y = pk2(s[2 * 33], s[3 * 33]); o.z = pk2(s[4 * 33], s[5 * 33]); o.w = pk2(s[6 * 33], s[7 * 33]);
        *(u32x4*)(WT + (size_t)(dr + n) * K + k0 + 8 * c) = o; }
    asm volatile("s_waitcnt lgkmcnt(0)" ::: "memory");
}
__device__ __forceinline__ void norm_rows(const float* X, const float* g, bf16* XN, int gw, int NGW, int lane) {
    f32x4 gv[4];
#pragma unroll
    for (int j = 0; j < 4; ++j) gv[j] = *((const f32x4*)g + lane + 64 * j);
    for (int m = gw; m < M; m += NGW) {
        const f32x4* xr = (const f32x4*)(X + (size_t)m * D) + lane;
        f32x4 v[4]; float s = 0.f;
#pragma unroll
        for (int j = 0; j < 4; ++j) { v[j] = xr[64 * j]; s += (v[j].x * v[j].x + v[j].y * v[j].y) + (v[j].z * v[j].z + v[j].w * v[j].w); }
        const float r = 1.0f / sqrtf(wave_sum(s) * (1.f / D) + EPS);
        u32x2* o = (u32x2*)(XN + (size_t)m * D) + lane;
#pragma unroll
        for (int j = 0; j < 4; ++j) { u32x2 w; w.x = pk2(v[j].x * r * gv[j].x, v[j].y * r * gv[j].y); w.y = pk2(v[j].z * r * gv[j].z, v[j].w * r * gv[j].w); o[64 * j] = w; }
    }
}
__device__ __forceinline__ void resid_rows(const float* F, const float* base, float* H, bf16* XN, const float* gpost, const float* gnext, float scale, int gw, int NGW, int lane) {
    for (int m = gw; m < M; m += NGW) {
        const f32x4* fr = (const f32x4*)(F + (size_t)m * D) + lane;
        const f32x4* br = (const f32x4*)(base + (size_t)m * D) + lane;
        f32x4 f[4], h[4]; float s = 0.f;
#pragma unroll
        for (int j = 0; j < 4; ++j) { f[j] = fr[64 * j]; h[j] = br[64 * j]; s += (f[j].x * f[j].x + f[j].y * f[j].y) + (f[j].z * f[j].z + f[j].w * f[j].w); }
        const float r = scale / sqrtf(wave_sum(s) * (1.f / D) + EPS);
        float s2 = 0.f;
        f32x4* ho = (f32x4*)(H + (size_t)m * D) + lane;
#pragma unroll
        for (int j = 0; j < 4; ++j) { const f32x4 g = *((const f32x4*)gpost + lane + 64 * j); h[j] = h[j] + f[j] * r * g; ho[64 * j] = h[j];
            s2 += (h[j].x * h[j].x + h[j].y * h[j].y) + (h[j].z * h[j].z + h[j].w * h[j].w); }
        if (XN) {
            const float r2 = 1.0f / sqrtf(wave_sum(s2) * (1.f / D) + EPS);
            u32x2* o = (u32x2*)(XN + (size_t)m * D) + lane;
#pragma unroll
            for (int j = 0; j < 4; ++j) { const f32x4 g = *((const f32x4*)gnext + lane + 64 * j);
                u32x2 w; w.x = pk2(h[j].x * r2 * g.x, h[j].y * r2 * g.y); w.y = pk2(h[j].z * r2 * g.z, h[j].w * r2 * g.w); o[64 * j] = w; }
        }
    }
}
__device__ __forceinline__ void rope_entry(int idx, float* tab) {
    const int pos = idx >> 5, d = idx & 31;
    const float ang = (float)pos * INV_FREQ[d];
    const double x = (double)ang;
    const double k = __builtin_rint(x * 0.63661977236758134308);
    const double r = __builtin_fma(-k, 1.57079632679489661923, x) - k * 6.123233995736766e-17;
    const double r2 = r * r;
    double sp = -1.0 / 39916800.0; sp = sp * r2 + 1.0 / 362880.0; sp = sp * r2 - 1.0 / 5040.0; sp = sp * r2 + 1.0 / 120.0; sp = sp * r2 - 1.0 / 6.0; sp = sp * r2 * r + r;
    double cp = 1.0 / 479001600.0; cp = cp * r2 - 1.0 / 3628800.0; cp = cp * r2 + 1.0 / 40320.0; cp = cp * r2 - 1.0 / 720.0; cp = cp * r2 + 1.0 / 24.0; cp = cp * r2 - 0.5; cp = cp * r2 + 1.0;
    const int q = ((int)k) & 3;
    const double c = (q == 0) ? cp : (q == 1) ? -sp : (q == 2) ? -cp : sp;
    const double s = (q == 0) ? sp : (q == 1) ? cp : (q == 2) ? -sp : -cp;
    tab[2 * idx] = (float)c; tab[2 * idx + 1] = (float)s;
}

constexpr int RL_XS = 0, RL_XC = 33280, RL_A = 70144, RL_B = 102912, RL_SA = 135680, RL_SH = 137728, RL_CARRY = 139776, RL_CW = 140032;
__device__ __forceinline__ void rec_unit(LAS unsigned char* lds, int unit, const bf16* XB, bf16* GB, const float* conv_w, const float* conv_b,
                                         const float* w_a, const float* b_a, const float* w_x, const float* b_x, const float* lam) {
    const int tid = threadIdx.x, lane = tid & 63, wid = tid >> 6, r32 = lane & 31, hi = lane >> 5;
    const int b = unit >> 5, n = (unit >> 1) & 15, half = unit & 1;
    LAS bf16* XS = (LAS bf16*)(lds + RL_XS);
    LAS bf16* XC = (LAS bf16*)(lds + RL_XC);
    LAS float* A32 = (LAS float*)(lds + RL_A);
    LAS float* B32 = (LAS float*)(lds + RL_B);
    LAS float* SA = (LAS float*)(lds + RL_SA);
    LAS float* SH = (LAS float*)(lds + RL_SH);
    LAS float* CARRY = (LAS float*)(lds + RL_CARRY);
    LAS float* CW = (LAS float*)(lds + RL_CW);
    if (tid < 256) CW[tid] = conv_w[(size_t)(tid >> 6) * D + n * 64 + (tid & 63)];
    else if (tid < 320) CW[tid] = conv_b[n * 64 + (tid & 63)];
    if (tid < 32) CARRY[tid] = 0.f;
    const int ch = n * 64 + half * 32 + r32;
    const float ba = b_a[ch], bx = b_x[ch];
    const float sp = log1pf(__expf(-lam[ch]));
    bf16x8 wa[4], wx[4];
#pragma unroll
    for (int ks = 0; ks < 4; ++ks)
#pragma unroll
        for (int j = 0; j < 8; ++j) {
            const size_t wi = ((size_t)n * 64 + 16 * ks + 8 * hi + j) * 64 + half * 32 + r32;
            wa[ks][j] = (short)(pk2(w_a[wi], 0.f) & 0xffffu); wx[ks][j] = (short)(pk2(w_x[wi], 0.f) & 0xffffu);
        }
    const size_t tokbase = (size_t)b * SEQ;
    const bf16* xsrc = XB + n * 64 + 8 * (tid & 7);
    u32x4 pre[5];
#pragma unroll
    for (int it = 0; it < 5; ++it) { const int i = (tid >> 3) + 64 * it, t = i - 3; pre[it] = (u32x4){0u, 0u, 0u, 0u};
        if (i < 259 && t >= 0) pre[it] = *(const u32x4*)(xsrc + (tokbase + t) * D); }
    for (int k = 0; k < SEQ / 256; ++k) {
        const int t0 = 256 * k;
#pragma unroll
        for (int it = 0; it < 5; ++it) { const int i = (tid >> 3) + 64 * it; if (i < 259) *(LAS u32x4*)(XS + i * 64 + 8 * (tid & 7)) = pre[it]; }
        __syncthreads();
        if (k + 1 < SEQ / 256) {
#pragma unroll
            for (int it = 0; it < 5; ++it) { const int i = (tid >> 3) + 64 * it, t = t0 + 256 + i - 3; if (i < 259) pre[it] = *(const u32x4*)(xsrc + (tokbase + t) * D); }
        }
#pragma unroll
        for (int it = 0; it < 4; ++it) {
            const int id = tid + 512 * it, g8 = id & 7, tt = id >> 3;
            float o[8];
            { const f32x4 c0 = *(const LAS f32x4*)(CW + 256 + 8 * g8), c1 = *(const LAS f32x4*)(CW + 256 + 8 * g8 + 4);
              o[0] = c0[0]; o[1] = c0[1]; o[2] = c0[2]; o[3] = c0[3]; o[4] = c1[0]; o[5] = c1[1]; o[6] = c1[2]; o[7] = c1[3]; }
#pragma unroll
            for (int tap = 0; tap < 4; ++tap) {
                const u32x4 xv = *(const LAS u32x4*)(XS + (tt + tap) * 64 + 8 * g8);
                const f32x4 c0 = *(const LAS f32x4*)(CW + 64 * tap + 8 * g8), c1 = *(const LAS f32x4*)(CW + 64 * tap + 8 * g8 + 4);
                o[0] += c0[0] * bflo(xv.x); o[1] += c0[1] * bfhi(xv.x); o[2] += c0[2] * bflo(xv.y); o[3] += c0[3] * bfhi(xv.y);
                o[4] += c1[0] * bflo(xv.z); o[5] += c1[1] * bfhi(xv.z); o[6] += c1[2] * bflo(xv.w); o[7] += c1[3] * bfhi(xv.w);
            }
            u32x4 w; w.x = pk2(o[0], o[1]); w.y = pk2(o[2], o[3]); w.z = pk2(o[4], o[5]); w.w = pk2(o[6], o[7]);
            *(LAS u32x4*)(XC + tt * 72 + 8 * g8) = w;
        }
        __syncthreads();
        f32x16 aa, ax;
#pragma unroll
        for (int i = 0; i < 16; ++i) { aa[i] = 0.f; ax[i] = 0.f; }
#pragma unroll
        for (int ks = 0; ks < 4; ++ks) {
            const bf16x8 af = *(const LAS bf16x8*)(XC + (32 * wid + r32) * 72 + 16 * ks + 8 * hi);
            aa = __builtin_amdgcn_mfma_f32_32x32x16_bf16(af, wa[ks], aa, 0, 0, 0);
            ax = __builtin_amdgcn_mfma_f32_32x32x16_bf16(af, wx[ks], ax, 0, 0, 0);
        }
#pragma unroll
        for (int i = 0; i < 16; ++i) {
            const int tok = 32 * wid + (i & 3) + 8 * (i >> 2) + 4 * hi;
            const float ra = sigmoidf_(aa[i] + ba), ii = sigmoidf_(ax[i] + bx);
            const float la = -8.0f * ra * sp;
            const float a = __expf(la);
            const float mult = sqrtf(fmaxf(-expm1f(2.0f * la), 0.f));
            const float xcv = bf2f(XC[tok * 72 + half * 32 + r32]);
            A32[tok * 32 + r32] = a; B32[tok * 32 + r32] = mult * ii * xcv;
        }
        __syncthreads();
        const int c = tid & 31, seg = tid >> 5;
        bf16* gptr = GB + (tokbase + t0 + 16 * seg) * D + n * 64 + half * 32 + c;
        bf16 gate[16];
#pragma unroll
        for (int j = 0; j < 16; ++j) gate[j] = gptr[(size_t)j * D];
        {
            float Aacc = 1.f, Hh = 0.f;
#pragma unroll
            for (int j = 0; j < 16; ++j) { const float a = A32[(16 * seg + j) * 32 + c], bb = B32[(16 * seg + j) * 32 + c]; Hh = a * Hh + bb; Aacc *= a; }
            SA[seg * 32 + c] = Aacc; SH[seg * 32 + c] = Hh;
        }
        __syncthreads();
        {
            float h = CARRY[(k & 1) * 32 + c];
            for (int s = 0; s < seg; ++s) h = SA[s * 32 + c] * h + SH[s * 32 + c];
#pragma unroll
            for (int j = 0; j < 16; ++j) { const float a = A32[(16 * seg + j) * 32 + c], bb = B32[(16 * seg + j) * 32 + c]; h = a * h + bb;
                gptr[(size_t)j * D] = (bf16)(pk2(h * bf2f(gate[j]), 0.f) & 0xffffu); }
            if (seg == 15) CARRY[((k + 1) & 1) * 32 + c] = h;
        }
    }
    __syncthreads();
}

constexpr int AT_KS = 0, AT_VT = 36864;
__device__ __forceinline__ void attn_unit(LAS unsigned char* lds, int unit, bf16* Q, const bf16* K, const bf16* V, const float* sinks) {
    const int tid = threadIdx.x, lane = tid & 63, wid = tid >> 6, r32 = lane & 31, hi = lane >> 5;
    const int b = unit >> 6, nb = (unit >> 2) & 15, kvh = unit & 3;
    LAS bf16* KS = (LAS bf16*)(lds + AT_KS);
    LAS bf16* VT = (LAS bf16*)(lds + AT_VT);
    const long rowq0 = (long)b * SEQ + nb * 128, rowk0 = rowq0 - 128;
#pragma unroll
    for (int it = 0; it < 4; ++it) {
        const int key = (tid >> 3) + 64 * it, cch = tid & 7;
        u32x4 kv = (u32x4){0u, 0u, 0u, 0u}, vv = (u32x4){0u, 0u, 0u, 0u};
        if (nb > 0 || key >= 128) { kv = *(const u32x4*)(K + (rowk0 + key) * 256 + kvh * 64 + 8 * cch); vv = *(const u32x4*)(V + (rowk0 + key) * 256 + kvh * 64 + 8 * cch); }
        *(LAS u32x4*)(KS + key * 72 + 8 * cch) = kv;
        const int pp = (key & ~15) + 8 * ((key >> 2) & 1) + 4 * ((key >> 3) & 1) + (key & 3);
        LAS bf16* vp = VT + (8 * cch) * 264 + pp;
        vp[0 * 264] = (bf16)(vv.x & 0xffffu); vp[1 * 264] = (bf16)(vv.x >> 16); vp[2 * 264] = (bf16)(vv.y & 0xffffu); vp[3 * 264] = (bf16)(vv.y >> 16);
        vp[4 * 264] = (bf16)(vv.z & 0xffffu); vp[5 * 264] = (bf16)(vv.z >> 16); vp[6 * 264] = (bf16)(vv.w & 0xffffu); vp[7 * 264] = (bf16)(vv.w >> 16);
    }
    const int g = wid >> 1, qh = wid & 1, hq = kvh * 4 + g;
    bf16* qbase = Q + (size_t)(rowq0 + 64 * qh + r32) * D + hq * 64;
    bf16x8 qf[2][4];
#pragma unroll
    for (int qi = 0; qi < 2; ++qi)
#pragma unroll
        for (int ks = 0; ks < 4; ++ks) qf[qi][ks] = *(const bf16x8*)(qbase + (size_t)(32 * qi) * D + 16 * ks + 8 * hi);
    const float sink2 = sinks[hq] * LOG2E;
    __syncthreads();
#pragma unroll
    for (int qi = 0; qi < 2; ++qi) {
        const int kt0 = 2 * qh + qi;
        f32x16 s[5];
#pragma unroll
        for (int j = 0; j < 5; ++j) {
#pragma unroll
            for (int i = 0; i < 16; ++i) s[j][i] = 0.f;
#pragma unroll
            for (int ks = 0; ks < 4; ++ks) {
                const bf16x8 kf = *(const LAS bf16x8*)(KS + (32 * (kt0 + j) + r32) * 72 + 16 * ks + 8 * hi);
                s[j] = __builtin_amdgcn_mfma_f32_32x32x16_bf16(kf, qf[qi][ks], s[j], 0, 0, 0);
            }
        }
        float mx = sink2;
#pragma unroll
        for (int j = 0; j < 5; ++j) {
            const bool tile_ok = (nb > 0) || (kt0 + j >= 4);
#pragma unroll
            for (int i = 0; i < 16; ++i) {
                const int kk = (i & 3) + 8 * (i >> 2) + 4 * hi;
                bool ok = tile_ok;
                if (j == 0) ok = ok && (kk > r32);
                if (j == 4) ok = ok && (kk <= r32);
                s[j][i] = ok ? s[j][i] : -1e30f;
                mx = fmaxf(mx, s[j][i]);
            }
        }
        mx = fmaxf(mx, __shfl_xor(mx, 32));
        float l = 0.f;
#pragma unroll
        for (int j = 0; j < 5; ++j)
#pragma unroll
            for (int i = 0; i < 16; ++i) { const float p = __builtin_amdgcn_exp2f(s[j][i] - mx); s[j][i] = p; l += p; }
        l += __shfl_xor(l, 32);
        l += __builtin_amdgcn_exp2f(sink2 - mx);
        f32x16 o[2];
#pragma unroll
        for (int i = 0; i < 16; ++i) { o[0][i] = 0.f; o[1][i] = 0.f; }
#pragma unroll
        for (int j = 0; j < 5; ++j)
#pragma unroll
            for (int s2 = 0; s2 < 2; ++s2) {
                u32x4 pw; pw.x = pk2(s[j][8 * s2 + 0], s[j][8 * s2 + 1]); pw.y = pk2(s[j][8 * s2 + 2], s[j][8 * s2 + 3]); pw.z = pk2(s[j][8 * s2 + 4], s[j][8 * s2 + 5]); pw.w = pk2(s[j][8 * s2 + 6], s[j][8 * s2 + 7]);
                const bf16x8 pf = __builtin_bit_cast(bf16x8, pw);
#pragma unroll
                for (int db = 0; db < 2; ++db) {
                    const bf16x8 vf = *(const LAS bf16x8*)(VT + (32 * db + r32) * 264 + 32 * (kt0 + j) + 16 * s2 + 8 * hi);
                    o[db] = __builtin_amdgcn_mfma_f32_32x32x16_bf16(vf, pf, o[db], 0, 0, 0);
                }
            }
        const float inv = 1.0f / l;
        bf16* op = qbase + (size_t)(32 * qi) * D;
#pragma unroll
        for (int db = 0; db < 2; ++db)
#pragma unroll
            for (int i4 = 0; i4 < 4; ++i4) {
                u32x2 w; w.x = pk2(o[db][4 * i4 + 0] * inv, o[db][4 * i4 + 1] * inv); w.y = pk2(o[db][4 * i4 + 2] * inv, o[db][4 * i4 + 3] * inv);
                *(u32x2*)(op + 32 * db + 8 * i4 + 4 * hi) = w;
            }
    }
    __syncthreads();
}

constexpr size_t WS_CTL = 244 * MiB; constexpr size_t CTL_BYTES = 16384; constexpr int MISC_OFF = LDS_BYTES - 64;
#define XB_TMO      128
#define XB_XCNT(j)  (256  + 64 * (j))
#define XB_XSUB(j)  (1280 + 64 * (j))
#define XB_XGEN(j)  (2304 + 64 * (j))
#define XB_TOP      3328
#define XB_TOPGEN   3392
#define XCD_BAR_WORDS 3456
#define XB_SPIN_CAP (1u << 18)

__device__ __forceinline__ unsigned xb_ld(unsigned* p)              { return __hip_atomic_load(p, __ATOMIC_RELAXED, __HIP_MEMORY_SCOPE_AGENT); }
__device__ __forceinline__ unsigned xb_add(unsigned* p, unsigned v) { return __hip_atomic_fetch_add(p, v, __ATOMIC_RELAXED, __HIP_MEMORY_SCOPE_AGENT); }
__device__ __forceinline__ unsigned xb_xcc_id() { return (unsigned)__builtin_amdgcn_s_getreg((3 << 11) | 20) & 0xFu; }
#define XB_SPIN(cond, bar) do { unsigned _sp = 0; while (cond) { __builtin_amdgcn_s_sleep(1); \
    if ((++_sp & 255u) == 0u) { if (xb_ld(&(bar)[XB_TMO])) break; if (_sp > XB_SPIN_CAP) { atomicAdd(&(bar)[XB_TMO], 1u); break; } } } } while (0)

struct XcdBarrier {
    unsigned* bar; unsigned x;
    volatile LAS unsigned* st;
};

__device__ __forceinline__ XcdBarrier xcd_barrier_post(unsigned* bar, volatile LAS unsigned* st) {
    XcdBarrier b; b.bar = bar; b.x = xb_xcc_id(); b.st = st;
    if (threadIdx.x == 0) (void)xb_add(&bar[XB_XCNT(b.x)], 1u);
    return b;
}
__device__ __forceinline__ void xcd_barrier_complete(unsigned* bar, unsigned x, unsigned& nloc, unsigned& nx) {
    const unsigned G = gridDim.x * gridDim.y * gridDim.z;
    unsigned sum, cnt, mine, sp = 0u;
    for (;;) {
        sum = 0u; cnt = 0u; mine = 0u;
#pragma unroll
        for (unsigned j = 0; j < 16; ++j) { const unsigned c = xb_ld(&bar[XB_XCNT(j)]); sum += c; cnt += (c > 0u) ? 1u : 0u; mine = (j == x) ? c : mine; }
        if (sum == G) break;
        __builtin_amdgcn_s_sleep(1);
        if ((++sp & 255u) == 0u) { if (xb_ld(&bar[XB_TMO])) break; if (sp > XB_SPIN_CAP) { atomicAdd(&bar[XB_TMO], 1u); break; } }
    }
    nloc = mine > 0u ? mine : 1u; nx = cnt > 0u ? cnt : 1u;
}

__device__ __forceinline__ void xcd_barrier(const XcdBarrier& b) {
    asm volatile("s_waitcnt vmcnt(0)" ::: "memory");
    __syncthreads();
    if (threadIdx.x == 0) {
        unsigned* bar = b.bar;
        __builtin_amdgcn_s_waitcnt(0);
        unsigned nloc = b.st[0], nx = b.st[1];
        if (nloc == 0u) { xcd_barrier_complete(bar, b.x, nloc, nx); b.st[0] = nloc; b.st[1] = nx; }
        const unsigned old = xb_add(&bar[XB_XSUB(b.x)], 1u);
        const unsigned gen = old / nloc;
        if (old + 1u == (gen + 1u) * nloc) {
            __builtin_amdgcn_fence(__ATOMIC_RELEASE, "agent");
            asm volatile("s_waitcnt vmcnt(0)" ::: "memory");
            const unsigned og = xb_add(&bar[XB_TOP], 1u);
            const unsigned tg = og / nx;
            if (og + 1u == (tg + 1u) * nx) xb_add(&bar[XB_TOPGEN], 1u);
            else XB_SPIN(xb_ld(&bar[XB_TOPGEN]) == tg, bar);
            __builtin_amdgcn_fence(__ATOMIC_ACQUIRE, "agent");
            xb_add(&bar[XB_XGEN(b.x)], 1u);
            asm volatile("s_waitcnt vmcnt(0)" ::: "memory");
        } else {
            XB_SPIN(xb_ld(&bar[XB_XGEN(b.x)]) == gen, bar);
            __builtin_amdgcn_fence(__ATOMIC_ACQUIRE, "agent");
            asm volatile("s_waitcnt vmcnt(0)" ::: "memory");
        }
    }
    __syncthreads();
}
struct Args { const float* in[23]; float* out; unsigned char* ws; int ph_lo, ph_hi; };
enum { I_X = 0, I_F1PRE, I_F1GU, I_F1DN, I_F1POST, I_MIXPRE, I_WIN, I_CONVW, I_CONVB, I_WA, I_BA, I_WX, I_BX, I_LAM, I_SINK, I_WPL, I_WPA, I_WOUT, I_MIXPOST, I_F2PRE, I_F2GU, I_F2DN, I_F2POST };

__global__ void __launch_bounds__(NTHREADS, 2) fwd(Args a) {
    extern __shared__ __attribute__((aligned(16))) unsigned char lds_raw[];
    LAS unsigned char* lds = (LAS unsigned char*)lds_raw;
    cg::grid_group grid = cg::this_grid();
    const int tid = threadIdx.x, lane = tid & 63, wave = __builtin_amdgcn_readfirstlane(tid >> 6);
    const int G = gridDim.x, bx = blockIdx.x;
    const int gw = bx * NWAVES + wave, NGW = G * NWAVES;
    unsigned char* ws = a.ws;
    bf16* WGU = (bf16*)(ws + WS_WGU); bf16* WD = (bf16*)(ws + WS_WD); bf16* WIN = (bf16*)(ws + WS_WIN);
    bf16* WPL = (bf16*)(ws + WS_WPL); bf16* WPA = (bf16*)(ws + WS_WPA); bf16* WOUT = (bf16*)(ws + WS_WOUT);
    float* ROPE = (float*)(ws + WS_ROPE);
    bf16* XN = (bf16*)(ws + WS_XN); bf16* ACT = (bf16*)(ws + WS_ACT); float* F = (float*)(ws + WS_F);
    bf16* GB = (bf16*)(ws + WS_GB); bf16* XB = (bf16*)(ws + WS_XB); bf16* Qb = (bf16*)(ws + WS_Q); bf16* Kb = (bf16*)(ws + WS_K); bf16* Vb = (bf16*)(ws + WS_V);
    bf16* GL = (bf16*)(ws + WS_GL); bf16* GA = (bf16*)(ws + WS_GA); bf16* MB = (bf16*)(ws + WS_MB);
    float* H = a.out;
    const int lo = a.ph_lo, hi = a.ph_hi;
    volatile LAS unsigned* st = (volatile LAS unsigned*)(lds + MISC_OFF);
    if (tid < 16) st[tid] = 0u;
    __syncthreads();
    XcdBarrier bar = xcd_barrier_post((unsigned*)(ws + WS_CTL), st);
#define IN(k) (lo <= (k) && (k) < hi)
#define SEAM(k) do { if (IN(k) && IN((k) + 1)) xcd_barrier(bar); } while (0)
    if (lo < 0) grid.sync();

    if (IN(0)) {
        LAS float* scr = (LAS float*)(lds + wave * 16384);
        constexpr int I_GU = (D / 64) * (NGU / 32), I_DN = (DFF / 64) * (D / 32), I_IN = (D / 64) * (NIN / 32), I_PR = (D / 64) * (D / 32);
        constexpr int NITEMS = I_GU + I_DN + I_IN + 3 * I_PR;
        for (int it = gw; it < NITEMS; it += NGW) {
            int r = it;
            if (r < I_GU) { transpose_item(a.in[I_F1GU], D, NGU, WGU, 1, scr, r, lane); continue; } r -= I_GU;
            if (r < I_DN) { transpose_item(a.in[I_F1DN], DFF, D, WD, 0, scr, r, lane); continue; } r -= I_DN;
            if (r < I_IN) { transpose_item(a.in[I_WIN], D, NIN, WIN, 2, scr, r, lane); continue; } r -= I_IN;
            if (r < I_PR) { transpose_item(a.in[I_WPL], D, D, WPL, 0, scr, r, lane); continue; } r -= I_PR;
            if (r < I_PR) { transpose_item(a.in[I_WPA], D, D, WPA, 0, scr, r, lane); continue; } r -= I_PR;
            transpose_item(a.in[I_WOUT], D, D, WOUT, 0, scr, r, lane);
        }
        for (int i = bx * NTHREADS + tid; i < SEQ * 32; i += G * NTHREADS) rope_entry(i, ROPE);
        norm_rows(a.in[I_X], a.in[I_F1PRE], XN, gw, NGW, lane);
    }
    SEAM(0);
    if (IN(1)) {
        __syncthreads();
        pg8::Gemm g{XN, WGU, M, NGU, D}; pg8::StaticOrder S; S.init(M, NGU, G, bx);
        pg8::EpiSwiglu E{ACT};
        pg8::gemm_phase<pg8::EpiSwiglu, pg8::StaticOrder, true, true>(lds, g, S, E);
    }
    SEAM(1);
    if (IN(2)) {
        pg8::Gemm g{ACT, WD, M, D, DFF}; pg8::StaticOrder S; S.init(M, D, G, bx);
        pg8::EpiF32 E{F, D};
        pg8::gemm_phase<pg8::EpiF32, pg8::StaticOrder, true, true>(lds, g, S, E);
    }
    SEAM(2);
    if (IN(3)) {
        LAS float* scr = (LAS float*)(lds + wave * 16384);
        constexpr int I_GU = (D / 64) * (NGU / 32), I_DN = (DFF / 64) * (D / 32);
        for (int it = gw; it < I_GU + I_DN; it += NGW) {
            if (it < I_GU) transpose_item(a.in[I_F2GU], D, NGU, WGU, 1, scr, it, lane);
            else transpose_item(a.in[I_F2DN], DFF, D, WD, 0, scr, it - I_GU, lane);
        }
        resid_rows(F, a.in[I_X], H, XN, a.in[I_F1POST], a.in[I_MIXPRE], 0.5f, gw, NGW, lane);
    }
    SEAM(3);
    if (IN(4)) {
        __syncthreads();
        pg8::Gemm g{XN, WIN, M, NIN, D}; pg8::StaticOrder S; S.init(M, NIN, G, bx);
        pg8::EpiMix E{GB, XB, Qb, Kb, Vb, GL, GA, ROPE};
        pg8::gemm_phase<pg8::EpiMix, pg8::StaticOrder, true, true>(lds, g, S, E);
    }
    SEAM(4);
    if (IN(5)) {
        for (int u = bx; u < BATCH * 16 * 2; u += G)
            rec_unit(lds, u, XB, GB, a.in[I_CONVW], a.in[I_CONVB], a.in[I_WA], a.in[I_BA], a.in[I_WX], a.in[I_BX], a.in[I_LAM]);
        for (int u = bx; u < BATCH * 16 * 4; u += G)
            attn_unit(lds, u, Qb, Kb, Vb, a.in[I_SINK]);
    }
    SEAM(5);
    if (IN(6)) {
        { pg8::Gemm g{GB, WPL, M, D, D}; pg8::StaticOrder S; S.init(M, D, G, bx);
          pg8::EpiGate<false> E{GL, MB};
          pg8::gemm_phase<pg8::EpiGate<false>, pg8::StaticOrder, true, true>(lds, g, S, E); }
        __syncthreads();
        { pg8::Gemm g{Qb, WPA, M, D, D}; pg8::StaticOrder S; S.init(M, D, G, bx);
          pg8::EpiGate<true> E{GA, MB};
          pg8::gemm_phase<pg8::EpiGate<true>, pg8::StaticOrder, true, true>(lds, g, S, E); }
    }
    SEAM(6);
    if (IN(7)) {
        pg8::Gemm g{MB, WOUT, M, D, D}; pg8::StaticOrder S; S.init(M, D, G, bx);
        pg8::EpiF32 E{F, D};
        pg8::gemm_phase<pg8::EpiF32, pg8::StaticOrder, true, true>(lds, g, S, E);
    }
    SEAM(7);
    if (IN(8)) resid_rows(F, H, H, XN, a.in[I_MIXPOST], a.in[I_F2PRE], 1.0f, gw, NGW, lane);
    SEAM(8);
    if (IN(9)) {
        pg8::Gemm g{XN, WGU, M, NGU, D}; pg8::StaticOrder S; S.init(M, NGU, G, bx);
        pg8::EpiSwiglu E{ACT};
        pg8::gemm_phase<pg8::EpiSwiglu, pg8::StaticOrder, true, true>(lds, g, S, E);
    }
    SEAM(9);
    if (IN(10)) {
        pg8::Gemm g{ACT, WD, M, D, DFF}; pg8::StaticOrder S; S.init(M, D, G, bx);
        pg8::EpiF32 E{F, D};
        pg8::gemm_phase<pg8::EpiF32, pg8::StaticOrder, true, true>(lds, g, S, E);
    }
    SEAM(10);
    if (IN(11)) resid_rows(F, H, H, nullptr, a.in[I_F2POST], nullptr, 0.5f, gw, NGW, lane);
#undef IN
#undef SEAM
}

#ifndef MK_PER_PHASE
#define MK_PER_PHASE 0
#endif
extern "C" void kernel_launch(void* const* d_in, const int* in_sizes, int n_in, void* d_out, int out_size, void* d_ws, size_t ws_size, hipStream_t stream) {
    static int grid = 0;
    if (grid == 0) {
        if (n_in != 23 || out_size != M * D || ws_size < WS_CTL + CTL_BYTES) { fprintf(stderr, "kernel_launch: unexpected shapes (n_in %d out %d ws %zu)\n", n_in, out_size, ws_size); grid = -1; return; }
        int dev = 0, cus = 0, per_cu = 0;
        if (hipGetDevice(&dev) != hipSuccess || hipDeviceGetAttribute(&cus, hipDeviceAttributeMultiprocessorCount, dev) != hipSuccess) { grid = -1; return; }
        if (hipFuncSetAttribute((const void*)fwd, hipFuncAttributeMaxDynamicSharedMemorySize, LDS_BYTES) != hipSuccess) { fprintf(stderr, "kernel_launch: hipFuncSetAttribute failed\n"); grid = -1; return; }
        if (hipOccupancyMaxActiveBlocksPerMultiprocessor(&per_cu, (const void*)fwd, NTHREADS, LDS_BYTES) != hipSuccess || per_cu < 1) per_cu = 1;
        (void)hipGetLastError();
        grid = cus * per_cu;
        fprintf(stderr, "kernel_launch: grid %d (cus %d x %d), ws %zu\n", grid, cus, per_cu, ws_size);
    }
    if (grid < 0) return;
    if (hipMemsetAsync((char*)d_ws + WS_CTL, 0, CTL_BYTES, stream) != hipSuccess) { fprintf(stderr, "kernel_launch: memset failed\n"); return; }
    Args a{};
    for (int i = 0; i < 23; ++i) a.in[i] = (const float*)d_in[i];
    a.out = (float*)d_out; a.ws = (unsigned char*)d_ws;
#if MK_PER_PHASE
    for (int p = 0; p < 12; ++p) { a.ph_lo = p; a.ph_hi = p + 1; hipLaunchKernelGGL(fwd, dim3(grid), dim3(NTHREADS), LDS_BYTES, stream, a); }
#else
    a.ph_lo = 0; a.ph_hi = 12;
    void* args[] = {&a};
    hipError_t e = hipLaunchCooperativeKernel((const void*)fwd, dim3(grid), dim3(NTHREADS), args, LDS_BYTES, stream);
    if (e != hipSuccess) fprintf(stderr, "kernel_launch: cooperative launch failed: %s (grid %d)\n", hipGetErrorString(e), grid);
#endif
}
```

```cpp
#include <hip/hip_runtime.h>
#include <hip/hip_cooperative_groups.h>
#include <cstdio>
#include <cstdint>
namespace cg = cooperative_groups;
namespace pg8 {
#define PG8_LAS __attribute__((address_space(3)))
typedef unsigned short bf16_t;
typedef short bf16x8 __attribute__((ext_vector_type(8)));
typedef float f32x4 __attribute__((ext_vector_type(4)));
typedef unsigned u32x4 __attribute__((ext_vector_type(4)));
constexpr int BM = 256, BK = 64, HALF = 128, HTB = HALF * BK * 2  , STAGE_BYTES = 8 * HTB, NXCD = 8, WGM = 8;

__host__ __device__ __forceinline__ int lds_byte(int r, int c) { const int st = (r >> 4) * 2 + (c >> 5), rr = r & 15, cc = c & 31, ob = rr * 64 + cc * 2; return st * 1024 + (ob ^ (((ob >> 9) & 1) << 5)); }
__host__ __device__ __forceinline__ void stage_rc(int b, int& R, int& C) { const int st = b / 1024, sb = b % 1024, swz = sb ^ (((sb >> 9) & 1) << 5); R = (st >> 1) * 16 + swz / 64; C = (st & 1) * 32 + (swz % 64) / 2; }
__host__ __device__ __forceinline__ int perm32(int rho) { const int n = rho >> 4, i = rho & 15; return 8 * (i >> 2) + 4 * n + (i & 3); }

struct Unit { int pm, pn; };
struct Gemm { const bf16_t* A; const bf16_t* Bt; int M, N, K; };

struct StaticOrder {
    int nM, nN, nwg, G, c;
    __host__ __device__ void init(int M, int N, int G_, int c_) { nM = M / BM; nN = N / BM; nwg = nM * nN; G = G_; c = c_; }
    __host__ __device__ bool next(int i, Unit& u) const {
        const long L = (long)i * G + c; if (L >= nwg) return false;
        int wgid = (int)L; { const int q = nwg / NXCD, r = nwg % NXCD, xcd = wgid % NXCD, off = wgid / NXCD; wgid = (xcd < r ? xcd * (q + 1) : r * (q + 1) + (xcd - r) * q) + off; }
        const int nig = WGM * nN, gid = wgid / nig, fm = gid * WGM, gsz = (nM - fm) < WGM ? (nM - fm) : WGM;
        u.pm = fm + ((wgid % nig) % gsz); u.pn = (wgid % nig) / gsz; return true;
    }
    __device__ __forceinline__ void a_ready(const Unit&) const {}
    __device__ __forceinline__ void done(const Unit&) const {}
};

__device__ __forceinline__ unsigned cvt_pk_bf16(float lo, float hi) { unsigned r; asm volatile("v_cvt_pk_bf16_f32 %0, %1, %2" : "=v"(r) : "v"(lo), "v"(hi)); return r; }
typedef float f32x2 __attribute__((ext_vector_type(2)));
template <class Epi, class Sched, bool ALIGN_EPI = false, bool SP2 = false>
__device__ __forceinline__ void gemm_phase(PG8_LAS unsigned char* lds, const Gemm g, const Sched& S, const Epi& E) {
    const int tid = threadIdx.x, wid = __builtin_amdgcn_readfirstlane(tid >> 6), lane = tid & 63, wr = wid >> 2, wc = wid & 3, fr = lane & 15, fq = lane >> 4;
    const int K = g.K, nt = K / BK;
    unsigned voffA[2], voffB[2];
#pragma unroll
    for (int i = 0; i < 2; ++i) { int R, C; stage_rc(tid * 16 + i * 8192, R, C); const int Rb = Epi::PERM ? ((R & ~31) + perm32(R & 31)) : R;
        voffA[i] = (unsigned)(R * K + C) * 2u; voffB[i] = (unsigned)(Rb * K + C) * 2u; }
    const size_t kstep = (size_t)(BK * 2);
    const size_t hstep = (size_t)HALF * K * 2;
    const size_t tstep = 2 * hstep;
    const unsigned ldsw = (unsigned)wid * 1024u;
    const int aoff = lds_byte(wr * 64 + fr, fq * 8), boff = lds_byte(wc * 32 + fr, fq * 8);
#define PG8_SA(b, h) (((b) * 2 + (h)) * HTB)
#define PG8_SB(b, h) ((4 + (b) * 2 + (h)) * HTB)
#define PG8_STAGE(bufoff, gbase, voff) do { _Pragma("unroll") for (int _i = 0; _i < 2; ++_i) \
        __builtin_amdgcn_global_load_lds((const unsigned*)((const char*)(gbase) + (voff)[_i]), (PG8_LAS unsigned*)(lds + (bufoff) + ldsw + _i * 8192), 16, 0, 0); } while (0)
#define PG8_LDA(dst, b, h) do { _Pragma("unroll") for (int m = 0; m < 4; ++m) _Pragma("unroll") for (int k = 0; k < 2; ++k) dst[m][k] = *(const PG8_LAS bf16x8*)(lds + PG8_SA(b, h) + aoff + m * 2048 + k * 1024); } while (0)
#define PG8_LDB(dst, b, h) do { _Pragma("unroll") for (int n = 0; n < 2; ++n) _Pragma("unroll") for (int k = 0; k < 2; ++k) dst[n][k] = *(const PG8_LAS bf16x8*)(lds + PG8_SB(b, h) + boff + n * 2048 + k * 1024); } while (0)
#define PG8_MMA(ai, bj, At, Bt) do { __builtin_amdgcn_s_setprio(1); _Pragma("unroll") for (int m = 0; m < 4; ++m) _Pragma("unroll") for (int n = 0; n < 2; ++n) _Pragma("unroll") for (int k = 0; k < 2; ++k) \
        acc[ai][bj][m][n] = __builtin_amdgcn_mfma_f32_16x16x32_bf16(Bt[n][k], At[m][k], acc[ai][bj][m][n], 0, 0, 0); __builtin_amdgcn_s_setprio(0); } while (0)
#define PG8_WAIT_V(n) asm volatile("s_waitcnt vmcnt(" #n ")" ::: "memory")
#define PG8_WAIT_L(n) asm volatile("s_waitcnt lgkmcnt(" #n ")" ::: "memory")
#define PG8_BAR __builtin_amdgcn_s_barrier()
#define PG8_SCHED __builtin_amdgcn_sched_barrier(0)
    Unit cur, nxt; int ui = 0;
    if (!S.next(0, cur)) return;
    f32x4 acc[2][2][4][2];
#pragma unroll
    for (int a = 0; a < 2; ++a)
#pragma unroll
        for (int b = 0; b < 2; ++b)
#pragma unroll
            for (int m = 0; m < 4; ++m)
#pragma unroll
                for (int n = 0; n < 2; ++n) acc[a][b][m][n] = (f32x4){0.f, 0.f, 0.f, 0.f};
    bf16x8 At[4][2], B0[2][2], B1[2][2];
    const char* cA = (const char*)g.A + (size_t)cur.pm * tstep; const char* cB = (const char*)g.Bt + (size_t)cur.pn * tstep;
    S.a_ready(cur);
    if constexpr (SP2) {
        PG8_STAGE(PG8_SB(0, 0), cB, voffB); PG8_STAGE(PG8_SB(0, 1), cB + hstep, voffB); PG8_STAGE(PG8_SA(0, 0), cA, voffA); PG8_STAGE(PG8_SA(0, 1), cA + hstep, voffA);
        if (wr == 1) PG8_BAR;
        PG8_WAIT_V(2); PG8_BAR;
        PG8_STAGE(PG8_SB(1, 0), cB + kstep, voffB); PG8_STAGE(PG8_SA(1, 0), cA + kstep, voffA); PG8_STAGE(PG8_SB(1, 1), cB + hstep + kstep, voffB);
        PG8_WAIT_V(6); PG8_BAR;
    } else {
        PG8_STAGE(PG8_SB(0, 0), cB, voffB); PG8_STAGE(PG8_SA(0, 0), cA, voffA); PG8_STAGE(PG8_SB(0, 1), cB + hstep, voffB); PG8_STAGE(PG8_SA(0, 1), cA + hstep, voffA);
        if (wr == 1) PG8_BAR;
        PG8_WAIT_V(4); PG8_BAR;
        PG8_STAGE(PG8_SB(1, 0), cB + kstep, voffB); PG8_STAGE(PG8_SA(1, 0), cA + kstep, voffA); PG8_STAGE(PG8_SB(1, 1), cB + hstep + kstep, voffB);
        PG8_WAIT_V(6); PG8_BAR;
    }
    for (;;) {
        const bool has_next = S.next(ui + 1, nxt);
        const char* nA = has_next ? (const char*)g.A + (size_t)nxt.pm * tstep : cA; const char* nB = has_next ? (const char*)g.Bt + (size_t)nxt.pn * tstep : cB;
        for (int t = 0; t < nt; t += 2) {
            const bool last = (t == nt - 2);
            const char* a1 = cA + (size_t)(t + 1) * kstep;
            const char* a2 = last ? nA : cA + (size_t)(t + 2) * kstep; const char* b2 = last ? nB : cB + (size_t)(t + 2) * kstep;
            const char* a3 = a2 + kstep; const char* b3 = b2 + kstep;
            if (last && has_next) S.a_ready(nxt);
            if constexpr (SP2) {
            PG8_LDB(B0, 0, 0); PG8_LDB(B1, 0, 1); PG8_SCHED; PG8_LDA(At, 0, 0); PG8_STAGE(PG8_SA(1, 1), a1 + hstep, voffA);
            PG8_WAIT_V(8); PG8_WAIT_L(0); PG8_BAR; PG8_MMA(0, 0, At, B0); PG8_MMA(0, 1, At, B1); PG8_BAR; PG8_SCHED;
            PG8_LDA(At, 0, 1); PG8_STAGE(PG8_SB(0, 0), b2, voffB); PG8_STAGE(PG8_SB(0, 1), b2 + hstep, voffB); PG8_STAGE(PG8_SA(0, 0), a2, voffA);
            PG8_WAIT_V(8); PG8_WAIT_L(0); PG8_BAR; PG8_MMA(1, 0, At, B0); PG8_MMA(1, 1, At, B1); PG8_BAR; PG8_SCHED;
            PG8_LDB(B0, 1, 0); PG8_LDB(B1, 1, 1); PG8_SCHED; PG8_LDA(At, 1, 0); PG8_STAGE(PG8_SA(0, 1), a2 + hstep, voffA);
            PG8_WAIT_V(8); PG8_WAIT_L(0); PG8_BAR; PG8_MMA(0, 0, At, B0); PG8_MMA(0, 1, At, B1); PG8_BAR; PG8_SCHED;
            PG8_LDA(At, 1, 1); PG8_STAGE(PG8_SB(1, 0), b3, voffB); PG8_STAGE(PG8_SB(1, 1), b3 + hstep, voffB); PG8_STAGE(PG8_SA(1, 0), a3, voffA);
            PG8_WAIT_V(8); PG8_WAIT_L(0); PG8_BAR; PG8_MMA(1, 0, At, B0); PG8_MMA(1, 1, At, B1); PG8_BAR; PG8_SCHED;
            } else {
            PG8_LDB(B0, 0, 0); PG8_SCHED; PG8_LDA(At, 0, 0); PG8_STAGE(PG8_SA(1, 1), a1 + hstep, voffA);
            PG8_WAIT_L(8); PG8_BAR; PG8_WAIT_L(0); PG8_MMA(0, 0, At, B0); PG8_BAR; PG8_SCHED;
            PG8_LDB(B1, 0, 1); PG8_STAGE(PG8_SB(0, 0), b2, voffB);
            PG8_BAR; PG8_WAIT_L(0); PG8_MMA(0, 1, At, B1); PG8_BAR;
            PG8_LDA(At, 0, 1); PG8_STAGE(PG8_SA(0, 0), a2, voffA);
            PG8_BAR; PG8_WAIT_L(0); PG8_MMA(1, 0, At, B0); PG8_BAR; PG8_SCHED;
            PG8_STAGE(PG8_SB(0, 1), b2 + hstep, voffB);
            PG8_WAIT_V(6); PG8_BAR; PG8_MMA(1, 1, At, B1); PG8_BAR;
            PG8_LDB(B0, 1, 0); PG8_SCHED; PG8_LDA(At, 1, 0); PG8_STAGE(PG8_SA(0, 1), a2 + hstep, voffA);
            PG8_WAIT_L(8); PG8_BAR; PG8_WAIT_L(0); PG8_MMA(0, 0, At, B0); PG8_BAR; PG8_SCHED;
            PG8_LDB(B1, 1, 1); PG8_STAGE(PG8_SB(1, 0), b3, voffB);
            PG8_BAR; PG8_WAIT_L(0); PG8_MMA(0, 1, At, B1); PG8_BAR;
            PG8_LDA(At, 1, 1); PG8_STAGE(PG8_SA(1, 0), a3, voffA);
            PG8_BAR; PG8_WAIT_L(0); PG8_MMA(1, 0, At, B0); PG8_BAR; PG8_SCHED;
            PG8_STAGE(PG8_SB(1, 1), b3 + hstep, voffB);
            PG8_WAIT_V(6); PG8_BAR; PG8_MMA(1, 1, At, B1); PG8_BAR;
            }
        }
        if constexpr (ALIGN_EPI) { if (wr == 0) PG8_BAR; }
        if constexpr (!Epi::AFTER_DRAIN) { E(acc, cur, wr, wc, fr, fq); S.done(cur); }
        if (!has_next) break;
#pragma unroll
        for (int a = 0; a < 2; ++a)
#pragma unroll
            for (int b = 0; b < 2; ++b)
#pragma unroll
                for (int m = 0; m < 4; ++m)
#pragma unroll
                    for (int n = 0; n < 2; ++n) acc[a][b][m][n] = (f32x4){0.f, 0.f, 0.f, 0.f};
        cur = nxt; cA = nA; cB = nB; ++ui;
        if constexpr (ALIGN_EPI) { if (wr == 1) PG8_BAR; }
    }
    PG8_WAIT_V(0);
    if constexpr (!ALIGN_EPI) { if (wr == 0) PG8_BAR; }
    PG8_BAR;
    if constexpr (Epi::AFTER_DRAIN) { E.fused(acc, cur, wr, wc, fr, fq, lds, wid, lane); S.done(cur); }
#undef PG8_SA
#undef PG8_SB
#undef PG8_STAGE
#undef PG8_LDA
#undef PG8_LDB
#undef PG8_MMA
#undef PG8_WAIT_V
#undef PG8_WAIT_L
#undef PG8_BAR
#undef PG8_SCHED
}
}

#ifndef PROBE
#define PROBE 0
#endif
#ifndef MK_PER_PHASE
#define MK_PER_PHASE 0
#endif
constexpr int BATCH = 8, SEQ = 2048, D = 1024, M = BATCH * SEQ, DFF = 2816, NGU = 2 * DFF, NIN = 5632;
constexpr float EPS = 1e-6f, LOG2E = 1.4426950408889634f;
constexpr float QSCALE = 0.125f * LOG2E;
constexpr int NWAVES = 8, NTHREADS = 512;
constexpr int LDS_BYTES = 147456;

constexpr size_t MiB = 1u << 20;
constexpr size_t WS_WGU = 0, WS_WD = 11 * MiB, WS_WIN = 17 * MiB, WS_WPL = 28 * MiB, WS_WPA = 30 * MiB, WS_WOUT = 32 * MiB, WS_ROPE = 34 * MiB;
constexpr size_t WS_XN = 36 * MiB;
constexpr size_t WS_GB = 68 * MiB, WS_XB = 100 * MiB, WS_Q = 132 * MiB, WS_K = 164 * MiB, WS_V = 172 * MiB, WS_GL = 180 * MiB, WS_GA = 212 * MiB;
constexpr size_t WS_ACT = 68 * MiB;
constexpr size_t WS_F = 180 * MiB;
constexpr size_t WS_MB = WS_XB;
constexpr size_t WS_END = 244 * MiB;

#define LAS __attribute__((address_space(3)))
typedef unsigned short bf16;
typedef unsigned u32x4 __attribute__((ext_vector_type(4)));
typedef unsigned u32x2 __attribute__((ext_vector_type(2)));
typedef float f32x4 __attribute__((ext_vector_type(4)));
typedef float f32x2 __attribute__((ext_vector_type(2)));
typedef float f32x16 __attribute__((ext_vector_type(16)));
typedef short bf16x8 __attribute__((ext_vector_type(8)));

__device__ __forceinline__ unsigned pk2(float lo, float hi) { return pg8::cvt_pk_bf16(lo, hi); }
__device__ __forceinline__ float bflo(unsigned w) { return __uint_as_float(w << 16); }
__device__ __forceinline__ float bfhi(unsigned w) { return __uint_as_float(w & 0xffff0000u); }
__device__ __forceinline__ float bf2f(bf16 v) { return __uint_as_float((unsigned)v << 16); }
__device__ __forceinline__ float sigmoidf_(float x) { return __builtin_amdgcn_rcpf(1.f + __builtin_amdgcn_exp2f(-x * LOG2E)); }
__device__ __forceinline__ float siluf_(float x) { return x * sigmoidf_(x); }
__device__ __forceinline__ float gelu_tanh_(float x) { const float y = 0.7978845608028654f * (x + 0.044715f * x * x * x); return x * sigmoidf_(2.f * y); }
__device__ __forceinline__ float act_(float v, int act) { return act == 1 ? gelu_tanh_(v) : (act == 2 ? sigmoidf_(v) : v); }
__device__ __forceinline__ float wave_sum(float v) {
#pragma unroll
    for (int o = 1; o < 64; o <<= 1) v += __shfl_xor(v, o);
    return v;
}

namespace pg8 {
struct EpiSwiglu {
    static constexpr bool PERM = true, AFTER_DRAIN = false;
    bf16_t* O;
    __device__ __forceinline__ void operator()(const f32x4 (&acc)[2][2][4][2], const Unit& u, int wr, int wc, int fr, int fq) const {
        const int row0 = u.pm * BM + wr * 64 + fr, col0 = u.pn * 128 + wc * 32 + 8 * fq;
#pragma unroll
        for (int ai = 0; ai < 2; ++ai)
#pragma unroll
            for (int m = 0; m < 4; ++m) {
                bf16_t* p = O + (size_t)(row0 + ai * HALF + m * 16) * DFF + col0;
                const f32x4 g0 = acc[ai][0][m][0], g1 = acc[ai][0][m][1], u0 = acc[ai][1][m][0], u1 = acc[ai][1][m][1];
                u32x4 w;
                w.x = cvt_pk_bf16(siluf_(g0[0]) * u0[0], siluf_(g0[1]) * u0[1]); w.y = cvt_pk_bf16(siluf_(g0[2]) * u0[2], siluf_(g0[3]) * u0[3]);
                w.z = cvt_pk_bf16(siluf_(g1[0]) * u1[0], siluf_(g1[1]) * u1[1]); w.w = cvt_pk_bf16(siluf_(g1[2]) * u1[2], siluf_(g1[3]) * u1[3]);
                *(u32x4*)p = w;
            }
    }
};
struct EpiBf {
    static constexpr bool PERM = true, AFTER_DRAIN = false;
    bf16_t* O; int ldc;
    __device__ __forceinline__ void operator()(const f32x4 (&acc)[2][2][4][2], const Unit& u, int wr, int wc, int fr, int fq) const {
        const int row0 = u.pm * BM + wr * 64 + fr, col0 = u.pn * BM + wc * 32 + 8 * fq;
#pragma unroll
        for (int ai = 0; ai < 2; ++ai)
#pragma unroll
            for (int m = 0; m < 4; ++m) {
                bf16_t* p = O + (size_t)(row0 + ai * HALF + m * 16) * ldc + col0;
#pragma unroll
                for (int bj = 0; bj < 2; ++bj) {
                    const f32x4 v0 = acc[ai][bj][m][0], v1 = acc[ai][bj][m][1];
                    u32x4 w; w.x = cvt_pk_bf16(v0[0], v0[1]); w.y = cvt_pk_bf16(v0[2], v0[3]); w.z = cvt_pk_bf16(v1[0], v1[1]); w.w = cvt_pk_bf16(v1[2], v1[3]);
                    *(u32x4*)(p + bj * HALF) = w;
                }
            }
    }
};
struct EpiMix {
    static constexpr bool PERM = true, AFTER_DRAIN = false;
    bf16_t *GB, *XB, *Q, *K, *V, *GL, *GA; const float* rope;
    __device__ __forceinline__ void operator()(const f32x4 (&acc)[2][2][4][2], const Unit& u, int wr, int wc, int fr, int fq) const {
        const int pn = u.pn, row0 = u.pm * BM + wr * 64 + fr;
        if (pn >= 8 && pn <= 12) {
            const bool isq = pn < 12; bf16_t* base = isq ? Q + 256 * (pn - 8) : K; const int ld = isq ? D : 256; const float sc = isq ? QSCALE : 1.f;
            const int dd0 = 8 * fq, col = 64 * wc + dd0;
#pragma unroll
            for (int ai = 0; ai < 2; ++ai)
#pragma unroll
                for (int m = 0; m < 4; ++m) {
                    const int row = row0 + ai * HALF + m * 16, pos = row & (SEQ - 1);
                    const f32x4* tp = (const f32x4*)(rope + (size_t)(pos * 32 + dd0) * 2);
                    const f32x4 t0 = tp[0], t1 = tp[1], t2 = tp[2], t3 = tp[3];
                    const f32x4 xa = acc[ai][0][m][0], xb = acc[ai][0][m][1], ya = acc[ai][1][m][0], yb = acc[ai][1][m][1];
                    float c[8] = {t0[0], t0[2], t1[0], t1[2], t2[0], t2[2], t3[0], t3[2]};
                    float s[8] = {t0[1], t0[3], t1[1], t1[3], t2[1], t2[3], t3[1], t3[3]};
                    float x1[8] = {xa[0], xa[1], xa[2], xa[3], xb[0], xb[1], xb[2], xb[3]};
                    float x2[8] = {ya[0], ya[1], ya[2], ya[3], yb[0], yb[1], yb[2], yb[3]};
                    float o1[8], o2[8];
#pragma unroll
                    for (int j = 0; j < 8; ++j) { o1[j] = (x1[j] * c[j] - x2[j] * s[j]) * sc; o2[j] = (x2[j] * c[j] + x1[j] * s[j]) * sc; }
                    u32x4 w1, w2;
                    w1.x = cvt_pk_bf16(o1[0], o1[1]); w1.y = cvt_pk_bf16(o1[2], o1[3]); w1.z = cvt_pk_bf16(o1[4], o1[5]); w1.w = cvt_pk_bf16(o1[6], o1[7]);
                    w2.x = cvt_pk_bf16(o2[0], o2[1]); w2.y = cvt_pk_bf16(o2[2], o2[3]); w2.z = cvt_pk_bf16(o2[4], o2[5]); w2.w = cvt_pk_bf16(o2[6], o2[7]);
                    bf16_t* p = base + (size_t)row * ld + col;
                    *(u32x4*)p = w1; *(u32x4*)(p + 32) = w2;
                }
        } else {
            bf16_t* base; int ld = D, act = 0;
            if (pn < 4) { base = GB + 256 * pn; act = 1; }
            else if (pn < 8) { base = XB + 256 * (pn - 4); }
            else if (pn == 13) { base = V; ld = 256; }
            else if (pn < 18) { base = GL + 256 * (pn - 14); act = 2; }
            else { base = GA + 256 * (pn - 18); act = 2; }
            const int col0 = wc * 32 + 8 * fq;
#pragma unroll
            for (int ai = 0; ai < 2; ++ai)
#pragma unroll
                for (int m = 0; m < 4; ++m) {
                    bf16_t* p = base + (size_t)(row0 + ai * HALF + m * 16) * ld + col0;
#pragma unroll
                    for (int bj = 0; bj < 2; ++bj) {
                        const f32x4 v0 = acc[ai][bj][m][0], v1 = acc[ai][bj][m][1];
                        u32x4 w;
                        w.x = cvt_pk_bf16(act_(v0[0], act), act_(v0[1], act)); w.y = cvt_pk_bf16(act_(v0[2], act), act_(v0[3], act));
                        w.z = cvt_pk_bf16(act_(v1[0], act), act_(v1[1], act)); w.w = cvt_pk_bf16(act_(v1[2], act), act_(v1[3], act));
                        *(u32x4*)(p + bj * HALF) = w;
                    }
                }
        }
    }
};
template <bool SECOND> struct EpiGate {
    static constexpr bool PERM = true, AFTER_DRAIN = false;
    const bf16_t* G; bf16_t* MB;
    __device__ __forceinline__ void operator()(const f32x4 (&acc)[2][2][4][2], const Unit& u, int wr, int wc, int fr, int fq) const {
        const int row0 = u.pm * BM + wr * 64 + fr, col0 = u.pn * BM + wc * 32 + 8 * fq;
#pragma unroll
        for (int ai = 0; ai < 2; ++ai)
#pragma unroll
            for (int m = 0; m < 4; ++m)
#pragma unroll
                for (int bj = 0; bj < 2; ++bj) {
                    const size_t off = (size_t)(row0 + ai * HALF + m * 16) * D + col0 + bj * HALF;
                    const u32x4 g = *(const u32x4*)(G + off);
                    const f32x4 v0 = acc[ai][bj][m][0], v1 = acc[ai][bj][m][1];
                    float o[8] = {bflo(g.x) * v0[0], bfhi(g.x) * v0[1], bflo(g.y) * v0[2], bfhi(g.y) * v0[3], bflo(g.z) * v1[0], bfhi(g.z) * v1[1], bflo(g.w) * v1[2], bfhi(g.w) * v1[3]};
                    if (SECOND) { const u32x4 t = *(const u32x4*)(MB + off);
                        o[0] += bflo(t.x); o[1] += bfhi(t.x); o[2] += bflo(t.y); o[3] += bfhi(t.y); o[4] += bflo(t.z); o[5] += bfhi(t.z); o[6] += bflo(t.w); o[7] += bfhi(t.w); }
                    u32x4 w; w.x = cvt_pk_bf16(o[0], o[1]); w.y = cvt_pk_bf16(o[2], o[3]); w.z = cvt_pk_bf16(o[4], o[5]); w.w = cvt_pk_bf16(o[6], o[7]);
                    *(u32x4*)(MB + off) = w;
                }
    }
};
}

__constant__ float INV_FREQ[32] = {1.000000000e+00f, 7.498942614e-01f, 5.623413324e-01f, 4.216965139e-01f, 3.162277639e-01f, 2.371373773e-01f, 1.778279394e-01f, 1.333521307e-01f,
    1.000000015e-01f, 7.498941571e-02f, 5.623413250e-02f, 4.216965288e-02f, 3.162277490e-02f, 2.371373773e-02f, 1.778279431e-02f, 1.333521493e-02f,
    9.999999776e-03f, 7.498941850e-03f, 5.623413250e-03f, 4.216964822e-03f, 3.162277630e-03f, 2.371373586e-03f, 1.778279431e-03f, 1.333521446e-03f,
    1.000000047e-03f, 7.498942432e-04f, 5.623413017e-04f, 4.216965172e-04f, 3.162277571e-04f, 2.371373703e-04f, 1.778279402e-04f, 1.333521504e-04f};

__device__ __forceinline__ int dest_row(int mode, int n0) {
    if (mode == 1) { if (n0 < DFF) return 256 * (n0 / 128) + (n0 % 128); const int n1 = n0 - DFF; return 256 * (n1 / 128) + 128 + (n1 % 128); }
    if (mode == 2) { const int tile = n0 >> 8; if (tile >= 8 && tile <= 12) { const int c = n0 & 255, hit = c >> 6, half = (c >> 5) & 1; return (tile << 8) + 128 * half + 32 * hit; } return n0; }
    return n0;
}
__device__ __forceinline__ void transpose_item(const float* W, int K, int N, bf16* WT, int mode, LAS float* scr, int item, int lane) {
    const int nblk = N / 32, kb = item / nblk, nb = item % nblk, k0 = 64 * kb, n0 = 32 * nb;
#pragma unroll 8
    for (int i = 0; i < 32; ++i) { const int kk = 2 * i + (lane >> 5); scr[kk * 33 + (lane & 31)] = W[(size_t)(k0 + kk) * N + n0 + (lane & 31)]; }
    asm volatile("s_waitcnt lgkmcnt(0)" ::: "memory");
    const int c = lane & 7, dr = dest_row(mode, n0);
#pragma unroll
    for (int j = 0; j < 4; ++j) { const int n = (lane >> 3) + 8 * j; const LAS float* s = scr + (8 * c) * 33 + n;
        u32x4 o; o.x = pk2(s[0 * 33], s[1 * 33]); o.y = pk2(s[2 * 33], s[3 * 33]); o.z = pk2(s[4 * 33], s[5 * 33]); o.w = pk2(s[6 * 33], s[7 * 33]);
        *(u32x4*)(WT + (size_t)(dr + n) * K + k0 + 8 * c) = o; }
    asm volatile("s_waitcnt lgkmcnt(0)" ::: "memory");
}
__device__ __forceinline__ void norm_rows(const float* X, const float* g, bf16* XN, int gw, int NGW, int lane) {
    f32x4 gv[4];
#pragma unroll
    for (int j = 0; j < 4; ++j) gv[j] = *((const f32x4*)g + lane + 64 * j);
    for (int m = gw; m < M; m += NGW) {
        const f32x4* xr = (const f32x4*)(X + (size_t)m * D) + lane;
        f32x4 v[4]; float s = 0.f;
#pragma unroll
        for (int j = 0; j < 4; ++j) { v[j] = xr[64 * j]; s += (v[j].x * v[j].x + v[j].y * v[j].y) + (v[j].z * v[j].z + v[j].w * v[j].w); }
        const float r = 1.0f / sqrtf(wave_sum(s) * (1.f / D) + EPS);
        u32x2* o = (u32x2*)(XN + (size_t)m * D) + lane;
#pragma unroll
        for (int j = 0; j < 4; ++j) { u32x2 w; w.x = pk2(v[j].x * r * gv[j].x, v[j].y * r * gv[j].y); w.y = pk2(v[j].z * r * gv[j].z, v[j].w * r * gv[j].w); o[64 * j] = w; }
    }
}
__device__ __forceinline__ void resid_rows(const bf16* F, const float* base, float* H, bf16* XN, const float* gpost, const float* gnext, float scale, int gw, int NGW, int lane) {
    for (int m = gw; m < M; m += NGW) {
        const u32x2* fr = (const u32x2*)(F + (size_t)m * D) + lane;
        const f32x4* br = (const f32x4*)(base + (size_t)m * D) + lane;
        f32x4 f[4], h[4]; float s = 0.f;
#pragma unroll
        for (int j = 0; j < 4; ++j) { const u32x2 fw = fr[64 * j]; f[j] = (f32x4){bflo(fw.x), bfhi(fw.x), bflo(fw.y), bfhi(fw.y)}; h[j] = br[64 * j]; s += (f[j].x * f[j].x + f[j].y * f[j].y) + (f[j].z * f[j].z + f[j].w * f[j].w); }
        const float r = scale / sqrtf(wave_sum(s) * (1.f / D) + EPS);
        float s2 = 0.f;
        f32x4* ho = (f32x4*)(H + (size_t)m * D) + lane;
#pragma unroll
        for (int j = 0; j < 4; ++j) { const f32x4 g = *((const f32x4*)gpost + lane + 64 * j); h[j] = h[j] + f[j] * r * g; ho[64 * j] = h[j];
            s2 += (h[j].x * h[j].x + h[j].y * h[j].y) + (h[j].z * h[j].z + h[j].w * h[j].w); }
        if (XN) {
            const float r2 = 1.0f / sqrtf(wave_sum(s2) * (1.f / D) + EPS);
            u32x2* o = (u32x2*)(XN + (size_t)m * D) + lane;
#pragma unroll
            for (int j = 0; j < 4; ++j) { const f32x4 g = *((const f32x4*)gnext + lane + 64 * j);
                u32x2 w; w.x = pk2(h[j].x * r2 * g.x, h[j].y * r2 * g.y); w.y = pk2(h[j].z * r2 * g.z, h[j].w * r2 * g.w); o[64 * j] = w; }
        }
    }
}
__device__ __forceinline__ void rope_entry(int idx, float* tab) {
    const int pos = idx >> 5, d = idx & 31;
    const float ang = (float)pos * INV_FREQ[d];
    const double x = (double)ang;
    const double k = __builtin_rint(x * 0.63661977236758134308);
    const double r = __builtin_fma(-k, 1.57079632679489661923, x) - k * 6.123233995736766e-17;
    const double r2 = r * r;
    double sp = -1.0 / 39916800.0; sp = sp * r2 + 1.0 / 362880.0; sp = sp * r2 - 1.0 / 5040.0; sp = sp * r2 + 1.0 / 120.0; sp = sp * r2 - 1.0 / 6.0; sp = sp * r2 * r + r;
    double cp = 1.0 / 479001600.0; cp = cp * r2 - 1.0 / 3628800.0; cp = cp * r2 + 1.0 / 40320.0; cp = cp * r2 - 1.0 / 720.0; cp = cp * r2 + 1.0 / 24.0; cp = cp * r2 - 0.5; cp = cp * r2 + 1.0;
    const int q = ((int)k) & 3;
    const double c = (q == 0) ? cp : (q == 1) ? -sp : (q == 2) ? -cp : sp;
    const double s = (q == 0) ? sp : (q == 1) ? cp : (q == 2) ? -sp : -cp;
    tab[2 * idx] = (float)c; tab[2 * idx + 1] = (float)s;
}

constexpr int RL_XS = 0, RL_XC = 33280, RL_A = 70144, RL_B = 102912, RL_SA = 135680, RL_SH = 137728, RL_CARRY = 139776, RL_CW = 140032;
__device__ __forceinline__ void rec_unit(LAS unsigned char* lds, int unit, const bf16* XB, const bf16* GB, bf16* YO, const float* conv_w, const float* conv_b,
                                         const float* w_a, const float* b_a, const float* w_x, const float* b_x, const float* lam) {
    const int tid = threadIdx.x, lane = tid & 63, wid = tid >> 6, r32 = lane & 31, hi = lane >> 5;
    const int b = unit >> 5, n = (unit >> 1) & 15, half = unit & 1;
    LAS bf16* XS = (LAS bf16*)(lds + RL_XS);
    LAS bf16* XC = (LAS bf16*)(lds + RL_XC);
    LAS float* A32 = (LAS float*)(lds + RL_A);
    LAS float* B32 = (LAS float*)(lds + RL_B);
    LAS float* SA = (LAS float*)(lds + RL_SA);
    LAS float* SH = (LAS float*)(lds + RL_SH);
    LAS float* CARRY = (LAS float*)(lds + RL_CARRY);
    LAS float* CW = (LAS float*)(lds + RL_CW);
    if (tid < 256) CW[tid] = conv_w[(size_t)(tid >> 6) * D + n * 64 + (tid & 63)];
    else if (tid < 320) CW[tid] = conv_b[n * 64 + (tid & 63)];
    if (tid < 32) CARRY[tid] = 0.f;
    const int ch = n * 64 + half * 32 + r32;
    const float ba = b_a[ch], bx = b_x[ch];
    const float sp = log1pf(__expf(-lam[ch]));
    bf16x8 wa[4], wx[4];
#pragma unroll
    for (int ks = 0; ks < 4; ++ks)
#pragma unroll
        for (int j = 0; j < 8; ++j) {
            const size_t wi = ((size_t)n * 64 + 16 * ks + 8 * hi + j) * 64 + half * 32 + r32;
            wa[ks][j] = (short)(pk2(w_a[wi], 0.f) & 0xffffu); wx[ks][j] = (short)(pk2(w_x[wi], 0.f) & 0xffffu);
        }
    const size_t tokbase = (size_t)b * SEQ;
    const bf16* xsrc = XB + n * 64 + 8 * (tid & 7);
    u32x4 pre[5];
#pragma unroll
    for (int it = 0; it < 5; ++it) { const int i = (tid >> 3) + 64 * it, t = i - 3; pre[it] = (u32x4){0u, 0u, 0u, 0u};
        if (i < 259 && t >= 0) pre[it] = *(const u32x4*)(xsrc + (tokbase + t) * D); }
    for (int k = 0; k < SEQ / 256; ++k) {
        const int t0 = 256 * k;
#pragma unroll
        for (int it = 0; it < 5; ++it) { const int i = (tid >> 3) + 64 * it; if (i < 259) *(LAS u32x4*)(XS + i * 64 + 8 * (tid & 7)) = pre[it]; }
        __syncthreads();
        if (k + 1 < SEQ / 256) {
#pragma unroll
            for (int it = 0; it < 5; ++it) { const int i = (tid >> 3) + 64 * it, t = t0 + 256 + i - 3; if (i < 259) pre[it] = *(const u32x4*)(xsrc + (tokbase + t) * D); }
        }
#pragma unroll
        for (int it = 0; it < 4; ++it) {
            const int id = tid + 512 * it, g8 = id & 7, tt = id >> 3;
            float o[8];
            { const f32x4 c0 = *(const LAS f32x4*)(CW + 256 + 8 * g8), c1 = *(const LAS f32x4*)(CW + 256 + 8 * g8 + 4);
              o[0] = c0[0]; o[1] = c0[1]; o[2] = c0[2]; o[3] = c0[3]; o[4] = c1[0]; o[5] = c1[1]; o[6] = c1[2]; o[7] = c1[3]; }
#pragma unroll
            for (int tap = 0; tap < 4; ++tap) {
                const u32x4 xv = *(const LAS u32x4*)(XS + (tt + tap) * 64 + 8 * g8);
                const f32x4 c0 = *(const LAS f32x4*)(CW + 64 * tap + 8 * g8), c1 = *(const LAS f32x4*)(CW + 64 * tap + 8 * g8 + 4);
                o[0] += c0[0] * bflo(xv.x); o[1] += c0[1] * bfhi(xv.x); o[2] += c0[2] * bflo(xv.y); o[3] += c0[3] * bfhi(xv.y);
                o[4] += c1[0] * bflo(xv.z); o[5] += c1[1] * bfhi(xv.z); o[6] += c1[2] * bflo(xv.w); o[7] += c1[3] * bfhi(xv.w);
            }
            u32x4 w; w.x = pk2(o[0], o[1]); w.y = pk2(o[2], o[3]); w.z = pk2(o[4], o[5]); w.w = pk2(o[6], o[7]);
            *(LAS u32x4*)(XC + tt * 72 + 8 * g8) = w;
        }
        __syncthreads();
        f32x16 aa, ax;
#pragma unroll
        for (int i = 0; i < 16; ++i) { aa[i] = 0.f; ax[i] = 0.f; }
#pragma unroll
        for (int ks = 0; ks < 4; ++ks) {
            const bf16x8 af = *(const LAS bf16x8*)(XC + (32 * wid + r32) * 72 + 16 * ks + 8 * hi);
            aa = __builtin_amdgcn_mfma_f32_32x32x16_bf16(af, wa[ks], aa, 0, 0, 0);
            ax = __builtin_amdgcn_mfma_f32_32x32x16_bf16(af, wx[ks], ax, 0, 0, 0);
        }
#pragma unroll
        for (int i = 0; i < 16; ++i) {
            const int tok = 32 * wid + (i & 3) + 8 * (i >> 2) + 4 * hi;
            const float ra = sigmoidf_(aa[i] + ba), ii = sigmoidf_(ax[i] + bx);
            const float la = -8.0f * ra * sp;
            const float a = __expf(la);
            const float mult = sqrtf(fmaxf(-expm1f(2.0f * la), 0.f));
            const float xcv = bf2f(XC[tok * 72 + half * 32 + r32]);
            A32[tok * 32 + r32] = a; B32[tok * 32 + r32] = mult * ii * xcv;
        }
        __syncthreads();
        const int c = tid & 31, seg = tid >> 5;
        const size_t goff = (tokbase + t0 + 16 * seg) * D + n * 64 + half * 32 + c;
        const bf16* gptr = GB + goff; bf16* yptr = YO + goff;
        bf16 gate[16];
#pragma unroll
        for (int j = 0; j < 16; ++j) gate[j] = gptr[(size_t)j * D];
        {
            float Aacc = 1.f, Hh = 0.f;
#pragma unroll
            for (int j = 0; j < 16; ++j) { const float a = A32[(16 * seg + j) * 32 + c], bb = B32[(16 * seg + j) * 32 + c]; Hh = a * Hh + bb; Aacc *= a; }
            SA[seg * 32 + c] = Aacc; SH[seg * 32 + c] = Hh;
        }
        __syncthreads();
        {
            float h = CARRY[(k & 1) * 32 + c];
            for (int s = 0; s < seg; ++s) h = SA[s * 32 + c] * h + SH[s * 32 + c];
#pragma unroll
            for (int j = 0; j < 16; ++j) { const float a = A32[(16 * seg + j) * 32 + c], bb = B32[(16 * seg + j) * 32 + c]; h = a * h + bb;
                yptr[(size_t)j * D] = (bf16)(pk2(h * bf2f(gate[j]), 0.f) & 0xffffu); }
            if (seg == 15) CARRY[((k + 1) & 1) * 32 + c] = h;
        }
    }
    __syncthreads();
}

constexpr int AT_KS = 0, AT_VT = 36864;
__device__ __forceinline__ void attn_unit(LAS unsigned char* lds, int unit, const bf16* Q, bf16* YO, const bf16* K, const bf16* V, const float* sinks) {
    const int tid = threadIdx.x, lane = tid & 63, wid = tid >> 6, r32 = lane & 31, hi = lane >> 5;
    const int b = unit >> 6, nb = (unit >> 2) & 15, kvh = unit & 3;
    LAS bf16* KS = (LAS bf16*)(lds + AT_KS);
    LAS bf16* VT = (LAS bf16*)(lds + AT_VT);
    const long rowq0 = (long)b * SEQ + nb * 128, rowk0 = rowq0 - 128;
#pragma unroll
    for (int it = 0; it < 4; ++it) {
        const int key = (tid >> 3) + 64 * it, cch = tid & 7;
        u32x4 kv = (u32x4){0u, 0u, 0u, 0u}, vv = (u32x4){0u, 0u, 0u, 0u};
        if (nb > 0 || key >= 128) { kv = *(const u32x4*)(K + (rowk0 + key) * 256 + kvh * 64 + 8 * cch); vv = *(const u32x4*)(V + (rowk0 + key) * 256 + kvh * 64 + 8 * cch); }
        *(LAS u32x4*)(KS + key * 72 + 8 * cch) = kv;
        const int pp = (key & ~15) + 8 * ((key >> 2) & 1) + 4 * ((key >> 3) & 1) + (key & 3);
        LAS bf16* vp = VT + (8 * cch) * 264 + pp;
        vp[0 * 264] = (bf16)(vv.x & 0xffffu); vp[1 * 264] = (bf16)(vv.x >> 16); vp[2 * 264] = (bf16)(vv.y & 0xffffu); vp[3 * 264] = (bf16)(vv.y >> 16);
        vp[4 * 264] = (bf16)(vv.z & 0xffffu); vp[5 * 264] = (bf16)(vv.z >> 16); vp[6 * 264] = (bf16)(vv.w & 0xffffu); vp[7 * 264] = (bf16)(vv.w >> 16);
    }
    const int g = wid >> 1, qh = wid & 1, hq = kvh * 4 + g;
    const size_t qoff = (size_t)(rowq0 + 64 * qh + r32) * D + hq * 64;
    const bf16* qbase = Q + qoff; bf16* obase = YO + qoff;
    bf16x8 qf[2][4];
#pragma unroll
    for (int qi = 0; qi < 2; ++qi)
#pragma unroll
        for (int ks = 0; ks < 4; ++ks) qf[qi][ks] = *(const bf16x8*)(qbase + (size_t)(32 * qi) * D + 16 * ks + 8 * hi);
    const float sink2 = sinks[hq] * LOG2E;
    __syncthreads();
#pragma unroll
    for (int qi = 0; qi < 2; ++qi) {
        const int kt0 = 2 * qh + qi;
        f32x16 s[5];
#pragma unroll
        for (int j = 0; j < 5; ++j) {
#pragma unroll
            for (int i = 0; i < 16; ++i) s[j][i] = 0.f;
#pragma unroll
            for (int ks = 0; ks < 4; ++ks) {
                const bf16x8 kf = *(const LAS bf16x8*)(KS + (32 * (kt0 + j) + r32) * 72 + 16 * ks + 8 * hi);
                s[j] = __builtin_amdgcn_mfma_f32_32x32x16_bf16(kf, qf[qi][ks], s[j], 0, 0, 0);
            }
        }
        float mx = sink2;
#pragma unroll
        for (int j = 0; j < 5; ++j) {
            const bool tile_ok = (nb > 0) || (kt0 + j >= 4);
#pragma unroll
            for (int i = 0; i < 16; ++i) {
                const int kk = (i & 3) + 8 * (i >> 2) + 4 * hi;
                bool ok = tile_ok;
                if (j == 0) ok = ok && (kk > r32);
                if (j == 4) ok = ok && (kk <= r32);
                s[j][i] = ok ? s[j][i] : -1e30f;
                mx = fmaxf(mx, s[j][i]);
            }
        }
        mx = fmaxf(mx, __shfl_xor(mx, 32));
        float l = 0.f;
#pragma unroll
        for (int j = 0; j < 5; ++j)
#pragma unroll
            for (int i = 0; i < 16; ++i) { const float p = __builtin_amdgcn_exp2f(s[j][i] - mx); s[j][i] = p; l += p; }
        l += __shfl_xor(l, 32);
        l += __builtin_amdgcn_exp2f(sink2 - mx);
        f32x16 o[2];
#pragma unroll
        for (int i = 0; i < 16; ++i) { o[0][i] = 0.f; o[1][i] = 0.f; }
#pragma unroll
        for (int j = 0; j < 5; ++j)
#pragma unroll
            for (int s2 = 0; s2 < 2; ++s2) {
                u32x4 pw; pw.x = pk2(s[j][8 * s2 + 0], s[j][8 * s2 + 1]); pw.y = pk2(s[j][8 * s2 + 2], s[j][8 * s2 + 3]); pw.z = pk2(s[j][8 * s2 + 4], s[j][8 * s2 + 5]); pw.w = pk2(s[j][8 * s2 + 6], s[j][8 * s2 + 7]);
                const bf16x8 pf = __builtin_bit_cast(bf16x8, pw);
#pragma unroll
                for (int db = 0; db < 2; ++db) {
                    const bf16x8 vf = *(const LAS bf16x8*)(VT + (32 * db + r32) * 264 + 32 * (kt0 + j) + 16 * s2 + 8 * hi);
                    o[db] = __builtin_amdgcn_mfma_f32_32x32x16_bf16(vf, pf, o[db], 0, 0, 0);
                }
            }
        const float inv = 1.0f / l;
        bf16* op = obase + (size_t)(32 * qi) * D;
#pragma unroll
        for (int db = 0; db < 2; ++db)
#pragma unroll
            for (int i4 = 0; i4 < 4; ++i4) {
                u32x2 w; w.x = pk2(o[db][4 * i4 + 0] * inv, o[db][4 * i4 + 1] * inv); w.y = pk2(o[db][4 * i4 + 2] * inv, o[db][4 * i4 + 3] * inv);
                *(u32x2*)(op + 32 * db + 8 * i4 + 4 * hi) = w;
            }
    }
    __syncthreads();
}

constexpr size_t WS_CTL = 244 * MiB; constexpr size_t CTL_BYTES = 16384; constexpr int MISC_OFF = LDS_BYTES - 64;
#define XB_TMO      128
#define XB_XCNT(j)  (256  + 64 * (j))
#define XB_XSUB(j)  (1280 + 64 * (j))
#define XB_XGEN(j)  (2304 + 64 * (j))
#define XB_TOP      3328
#define XB_TOPGEN   3392
#define XCD_BAR_WORDS 3456
#define XB_SPIN_CAP (1u << 18)

__device__ __forceinline__ unsigned xb_ld(unsigned* p)              { return __hip_atomic_load(p, __ATOMIC_RELAXED, __HIP_MEMORY_SCOPE_AGENT); }
__device__ __forceinline__ unsigned xb_add(unsigned* p, unsigned v) { return __hip_atomic_fetch_add(p, v, __ATOMIC_RELAXED, __HIP_MEMORY_SCOPE_AGENT); }
__device__ __forceinline__ unsigned xb_xcc_id() { return (unsigned)__builtin_amdgcn_s_getreg((3 << 11) | 20) & 0xFu; }
#define XB_SPIN(cond, bar) do { unsigned _sp = 0; while (cond) { __builtin_amdgcn_s_sleep(1); \
    if ((++_sp & 255u) == 0u) { if (xb_ld(&(bar)[XB_TMO])) break; if (_sp > XB_SPIN_CAP) { atomicAdd(&(bar)[XB_TMO], 1u); break; } } } } while (0)

struct XcdBarrier {
    unsigned* bar; unsigned x;
    volatile LAS unsigned* st;
};

__device__ __forceinline__ XcdBarrier xcd_barrier_post(unsigned* bar, volatile LAS unsigned* st) {
    XcdBarrier b; b.bar = bar; b.x = xb_xcc_id(); b.st = st;
    if (threadIdx.x == 0) (void)xb_add(&bar[XB_XCNT(b.x)], 1u);
    return b;
}
__device__ __forceinline__ void xcd_barrier_complete(unsigned* bar, unsigned x, unsigned& nloc, unsigned& nx) {
    const unsigned G = gridDim.x * gridDim.y * gridDim.z;
    unsigned sum, cnt, mine, sp = 0u;
    for (;;) {
        sum = 0u; cnt = 0u; mine = 0u;
#pragma unroll
        for (unsigned j = 0; j < 16; ++j) { const unsigned c = xb_ld(&bar[XB_XCNT(j)]); sum += c; cnt += (c > 0u) ? 1u : 0u; mine = (j == x) ? c : mine; }
        if (sum == G) break;
        __builtin_amdgcn_s_sleep(1);
        if ((++sp & 255u) == 0u) { if (xb_ld(&bar[XB_TMO])) break; if (sp > XB_SPIN_CAP) { atomicAdd(&bar[XB_TMO], 1u); break; } }
    }
    nloc = mine > 0u ? mine : 1u; nx = cnt > 0u ? cnt : 1u;
}

__device__ __forceinline__ void xcd_barrier(const XcdBarrier& b) {
    asm volatile("s_waitcnt vmcnt(0)" ::: "memory");
    __syncthreads();
    if (threadIdx.x == 0) {
        unsigned* bar = b.bar;
        __builtin_amdgcn_s_waitcnt(0);
        unsigned nloc = b.st[0], nx = b.st[1];
        if (nloc == 0u) { xcd_barrier_complete(bar, b.x, nloc, nx); b.st[0] = nloc; b.st[1] = nx; }
        const unsigned old = xb_add(&bar[XB_XSUB(b.x)], 1u);
        const unsigned gen = old / nloc;
        if (old + 1u == (gen + 1u) * nloc) {
            __builtin_amdgcn_fence(__ATOMIC_RELEASE, "agent");
            asm volatile("s_waitcnt vmcnt(0)" ::: "memory");
            const unsigned og = xb_add(&bar[XB_TOP], 1u);
            const unsigned tg = og / nx;
            if (og + 1u == (tg + 1u) * nx) xb_add(&bar[XB_TOPGEN], 1u);
            else XB_SPIN(xb_ld(&bar[XB_TOPGEN]) == tg, bar);
            __builtin_amdgcn_fence(__ATOMIC_ACQUIRE, "agent");
            xb_add(&bar[XB_XGEN(b.x)], 1u);
            asm volatile("s_waitcnt vmcnt(0)" ::: "memory");
        } else {
            XB_SPIN(xb_ld(&bar[XB_XGEN(b.x)]) == gen, bar);
            __builtin_amdgcn_fence(__ATOMIC_ACQUIRE, "agent");
            asm volatile("s_waitcnt vmcnt(0)" ::: "memory");
        }
    }
    __syncthreads();
}
struct Args { const float* in[23]; float* out; unsigned char* ws; int ph_lo, ph_hi; };
enum { I_X = 0, I_F1PRE, I_F1GU, I_F1DN, I_F1POST, I_MIXPRE, I_WIN, I_CONVW, I_CONVB, I_WA, I_BA, I_WX, I_BX, I_LAM, I_SINK, I_WPL, I_WPA, I_WOUT, I_MIXPOST, I_F2PRE, I_F2GU, I_F2DN, I_F2POST };

__global__ void __launch_bounds__(NTHREADS, 2) fwd(Args a) {
    extern __shared__ __attribute__((aligned(16))) unsigned char lds_raw[];
    LAS unsigned char* lds = (LAS unsigned char*)lds_raw;
    cg::grid_group grid = cg::this_grid();
    const int tid = threadIdx.x, lane = tid & 63, wave = __builtin_amdgcn_readfirstlane(tid >> 6);
    const int G = gridDim.x, bx = blockIdx.x;
    const int gw = bx * NWAVES + wave, NGW = G * NWAVES;
    unsigned char* ws = a.ws;
    bf16* WGU = (bf16*)(ws + WS_WGU); bf16* WD = (bf16*)(ws + WS_WD); bf16* WIN = (bf16*)(ws + WS_WIN);
    bf16* WPL = (bf16*)(ws + WS_WPL); bf16* WPA = (bf16*)(ws + WS_WPA); bf16* WOUT = (bf16*)(ws + WS_WOUT);
    float* ROPE = (float*)(ws + WS_ROPE);
    bf16* XN = (bf16*)(ws + WS_XN); bf16* ACT = (bf16*)(ws + WS_ACT); bf16* F = (bf16*)(ws + WS_F);
    bf16* GB = (bf16*)(ws + WS_GB); bf16* XB = (bf16*)(ws + WS_XB); bf16* Qb = (bf16*)(ws + WS_Q); bf16* Kb = (bf16*)(ws + WS_K); bf16* Vb = (bf16*)(ws + WS_V);
    bf16* GL = (bf16*)(ws + WS_GL); bf16* GA = (bf16*)(ws + WS_GA); bf16* MB = (bf16*)(ws + WS_MB);
    float* H = a.out;
    const int lo = a.ph_lo, hi = a.ph_hi;
    volatile LAS unsigned* st = (volatile LAS unsigned*)(lds + MISC_OFF);
    if (tid < 16) st[tid] = 0u;
    __syncthreads();
    XcdBarrier bar = xcd_barrier_post((unsigned*)(ws + WS_CTL), st);
#define IN(k) (lo <= (k) && (k) < hi)
#define SEAM(k) do { if (IN(k) && IN((k) + 1)) xcd_barrier(bar); } while (0)
    if (lo < 0) grid.sync();

    if (IN(0)) {
        LAS float* scr = (LAS float*)(lds + wave * 16384);
        constexpr int I_GU = (D / 64) * (NGU / 32), I_DN = (DFF / 64) * (D / 32);
        for (int it = gw; it < I_GU + I_DN; it += NGW) {
            if (it < I_GU) transpose_item(a.in[I_F1GU], D, NGU, WGU, 1, scr, it, lane);
            else transpose_item(a.in[I_F1DN], DFF, D, WD, 0, scr, it - I_GU, lane);
        }
        for (int i = bx * NTHREADS + tid; i < SEQ * 32; i += G * NTHREADS) rope_entry(i, ROPE);
        norm_rows(a.in[I_X], a.in[I_F1PRE], XN, gw, NGW, lane);
    }
    SEAM(0);
    if (IN(1)) {
        __syncthreads();
        pg8::Gemm g{XN, WGU, M, NGU, D}; pg8::StaticOrder S; S.init(M, NGU, G, bx);
        pg8::EpiSwiglu E{ACT};
        pg8::gemm_phase<pg8::EpiSwiglu, pg8::StaticOrder, true, true>(lds, g, S, E);
        { const int rem = ((M / 256) * (NGU / 256)) % G, first = rem, nblk = G - rem;
          if (bx >= first) {
              LAS float* scr = (LAS float*)(lds + wave * 16384);
              constexpr int I_IN = (D / 64) * (NIN / 32), I_PR = (D / 64) * (D / 32);
              for (int it = (bx - first) * NWAVES + wave; it < I_IN + 3 * I_PR; it += nblk * NWAVES) {
                  int r = it;
                  if (r < I_IN) { transpose_item(a.in[I_WIN], D, NIN, WIN, 2, scr, r, lane); continue; } r -= I_IN;
                  if (r < I_PR) { transpose_item(a.in[I_WPL], D, D, WPL, 0, scr, r, lane); continue; } r -= I_PR;
                  if (r < I_PR) { transpose_item(a.in[I_WPA], D, D, WPA, 0, scr, r, lane); continue; } r -= I_PR;
                  transpose_item(a.in[I_WOUT], D, D, WOUT, 0, scr, r, lane);
              }
          } }
    }
    SEAM(1);
    if (IN(2)) {
        pg8::Gemm g{ACT, WD, M, D, DFF}; pg8::StaticOrder S; S.init(M, D, G, bx);
        pg8::EpiBf E{F, D};
        pg8::gemm_phase<pg8::EpiBf, pg8::StaticOrder, true, true>(lds, g, S, E);
    }
    SEAM(2);
    if (IN(3)) {
        resid_rows(F, a.in[I_X], H, XN, a.in[I_F1POST], a.in[I_MIXPRE], 0.5f, gw, NGW, lane);
    }
    SEAM(3);
    if (IN(4)) {
        __syncthreads();
        pg8::Gemm g{XN, WIN, M, NIN, D}; pg8::StaticOrder S; S.init(M, NIN, G, bx);
        pg8::EpiMix E{GB, XB, Qb, Kb, Vb, GL, GA, ROPE};
        pg8::gemm_phase<pg8::EpiMix, pg8::StaticOrder, true, true>(lds, g, S, E);
        { const int rem = ((M / 256) * (NIN / 256)) % G, first = rem, nblk = G - rem;
          if (bx >= first) {
              LAS float* scr = (LAS float*)(lds + wave * 16384);
              constexpr int I_GU = (D / 64) * (NGU / 32), I_DN = (DFF / 64) * (D / 32);
              for (int it = (bx - first) * NWAVES + wave; it < I_GU + I_DN; it += nblk * NWAVES) {
                  if (it < I_GU) transpose_item(a.in[I_F2GU], D, NGU, WGU, 1, scr, it, lane);
                  else transpose_item(a.in[I_F2DN], DFF, D, WD, 0, scr, it - I_GU, lane);
              }
          } }
    }
    SEAM(4);
    if (IN(5)) {
#if PROBE == 1
        for (int u = bx; u < BATCH * 16 * 2; u += G)
            rec_unit(lds, u, XB, GB, XN, a.in[I_CONVW], a.in[I_CONVB], a.in[I_WA], a.in[I_BA], a.in[I_WX], a.in[I_BX], a.in[I_LAM]);
#elif PROBE == 2
        for (int u = bx; u < BATCH * 16 * 4; u += G)
            attn_unit(lds, u, Qb, XN, Kb, Vb, a.in[I_SINK]);
#endif
        for (int u = bx; u < BATCH * 16 * 2; u += G)
            rec_unit(lds, u, XB, GB, GB, a.in[I_CONVW], a.in[I_CONVB], a.in[I_WA], a.in[I_BA], a.in[I_WX], a.in[I_BX], a.in[I_LAM]);
        for (int u = bx; u < BATCH * 16 * 4; u += G)
            attn_unit(lds, u, Qb, Qb, Kb, Vb, a.in[I_SINK]);
    }
    SEAM(5);
    if (IN(6)) {
        { pg8::Gemm g{GB, WPL, M, D, D}; pg8::StaticOrder S; S.init(M, D, G, bx);
          pg8::EpiGate<false> E{GL, MB};
          pg8::gemm_phase<pg8::EpiGate<false>, pg8::StaticOrder, true, true>(lds, g, S, E); }
        __syncthreads();
        { pg8::Gemm g{Qb, WPA, M, D, D}; pg8::StaticOrder S; S.init(M, D, G, bx);
          pg8::EpiGate<true> E{GA, MB};
          pg8::gemm_phase<pg8::EpiGate<true>, pg8::StaticOrder, true, true>(lds, g, S, E); }
    }
    SEAM(6);
    if (IN(7)) {
        pg8::Gemm g{MB, WOUT, M, D, D}; pg8::StaticOrder S; S.init(M, D, G, bx);
        pg8::EpiBf E{F, D};
        pg8::gemm_phase<pg8::EpiBf, pg8::StaticOrder, true, true>(lds, g, S, E);
    }
    SEAM(7);
    if (IN(8)) resid_rows(F, H, H, XN, a.in[I_MIXPOST], a.in[I_F2PRE], 1.0f, gw, NGW, lane);
    SEAM(8);
    if (IN(9)) {
        pg8::Gemm g{XN, WGU, M, NGU, D}; pg8::StaticOrder S; S.init(M, NGU, G, bx);
        pg8::EpiSwiglu E{ACT};
        pg8::gemm_phase<pg8::EpiSwiglu, pg8::StaticOrder, true, true>(lds, g, S, E);
    }
    SEAM(9);
    if (IN(10)) {
        pg8::Gemm g{ACT, WD, M, D, DFF}; pg8::StaticOrder S; S.init(M, D, G, bx);
        pg8::EpiBf E{F, D};
        pg8::gemm_phase<pg8::EpiBf, pg8::StaticOrder, true, true>(lds, g, S, E);
    }
    SEAM(10);
    if (IN(11)) resid_rows(F, H, H, nullptr, a.in[I_F2POST], nullptr, 0.5f, gw, NGW, lane);
#undef IN
#undef SEAM
}

#ifndef MK_PER_PHASE_DUMMY
#define MK_PER_PHASE 0
#endif
extern "C" void kernel_launch(void* const* d_in, const int* in_sizes, int n_in, void* d_out, int out_size, void* d_ws, size_t ws_size, hipStream_t stream) {
    static int grid = 0;
    if (grid == 0) {
        if (n_in != 23 || out_size != M * D || ws_size < WS_CTL + CTL_BYTES) { fprintf(stderr, "kernel_launch: unexpected shapes (n_in %d out %d ws %zu)\n", n_in, out_size, ws_size); grid = -1; return; }
        int dev = 0, cus = 0, per_cu = 0;
        if (hipGetDevice(&dev) != hipSuccess || hipDeviceGetAttribute(&cus, hipDeviceAttributeMultiprocessorCount, dev) != hipSuccess) { grid = -1; return; }
        if (hipFuncSetAttribute((const void*)fwd, hipFuncAttributeMaxDynamicSharedMemorySize, LDS_BYTES) != hipSuccess) { fprintf(stderr, "kernel_launch: hipFuncSetAttribute failed\n"); grid = -1; return; }
        if (hipOccupancyMaxActiveBlocksPerMultiprocessor(&per_cu, (const void*)fwd, NTHREADS, LDS_BYTES) != hipSuccess || per_cu < 1) per_cu = 1;
        (void)hipGetLastError();
        grid = cus * per_cu;
        fprintf(stderr, "kernel_launch: grid %d (cus %d x %d), ws %zu\n", grid, cus, per_cu, ws_size);
    }
    if (grid < 0) return;
    if (hipMemsetAsync((char*)d_ws + WS_CTL, 0, CTL_BYTES, stream) != hipSuccess) { fprintf(stderr, "kernel_launch: memset failed\n"); return; }
    Args a{};
    for (int i = 0; i < 23; ++i) a.in[i] = (const float*)d_in[i];
    a.out = (float*)d_out; a.ws = (unsigned char*)d_ws;
#if MK_PER_PHASE
    for (int p = 0; p < 12; ++p) { a.ph_lo = p; a.ph_hi = p + 1; hipLaunchKernelGGL(fwd, dim3(grid), dim3(NTHREADS), LDS_BYTES, stream, a); }
#else
    a.ph_lo = 0; a.ph_hi = 12;
    void* args[] = {&a};
    hipError_t e = hipLaunchCooperativeKernel((const void*)fwd, dim3(grid), dim3(NTHREADS), args, LDS_BYTES, stream);
    if (e != hipSuccess) fprintf(stderr, "kernel_launch: cooperative launch failed: %s (grid %d)\n", hipGetErrorString(e), grid);
#endif
}
```

```cpp
#include <hip/hip_runtime.h>
#include <hip/hip_cooperative_groups.h>
#include <cstdio>
#include <cstdint>
namespace cg = cooperative_groups;
namespace pg8 {
#define PG8_LAS __attribute__((address_space(3)))
typedef unsigned short bf16_t;
typedef short bf16x8 __attribute__((ext_vector_type(8)));
typedef float f32x4 __attribute__((ext_vector_type(4)));
typedef unsigned u32x4 __attribute__((ext_vector_type(4)));
constexpr int BM = 256, BK = 64, HALF = 128, HTB = HALF * BK * 2  , STAGE_BYTES = 8 * HTB, NXCD = 8, WGM = 8;

__host__ __device__ __forceinline__ int lds_byte(int r, int c) { const int st = (r >> 4) * 2 + (c >> 5), rr = r & 15, cc = c & 31, ob = rr * 64 + cc * 2; return st * 1024 + (ob ^ (((ob >> 9) & 1) << 5)); }
__host__ __device__ __forceinline__ void stage_rc(int b, int& R, int& C) { const int st = b / 1024, sb = b % 1024, swz = sb ^ (((sb >> 9) & 1) << 5); R = (st >> 1) * 16 + swz / 64; C = (st & 1) * 32 + (swz % 64) / 2; }
__host__ __device__ __forceinline__ int perm32(int rho) { const int n = rho >> 4, i = rho & 15; return 8 * (i >> 2) + 4 * n + (i & 3); }

struct Unit { int pm, pn; };
struct Gemm { const bf16_t* A; const bf16_t* Bt; int M, N, K; };

struct StaticOrder {
    int nM, nN, nwg, G, c;
    __host__ __device__ void init(int M, int N, int G_, int c_) { nM = M / BM; nN = N / BM; nwg = nM * nN; G = G_; c = c_; }
    __host__ __device__ bool next(int i, Unit& u) const {
        const long L = (long)i * G + c; if (L >= nwg) return false;
        int wgid = (int)L; { const int q = nwg / NXCD, r = nwg % NXCD, xcd = wgid % NXCD, off = wgid / NXCD; wgid = (xcd < r ? xcd * (q + 1) : r * (q + 1) + (xcd - r) * q) + off; }
        const int nig = WGM * nN, gid = wgid / nig, fm = gid * WGM, gsz = (nM - fm) < WGM ? (nM - fm) : WGM;
        u.pm = fm + ((wgid % nig) % gsz); u.pn = (wgid % nig) / gsz; return true;
    }
    __device__ __forceinline__ void a_ready(const Unit&) const {}
    __device__ __forceinline__ void done(const Unit&) const {}
};

__device__ __forceinline__ unsigned cvt_pk_bf16(float lo, float hi) { unsigned r; asm volatile("v_cvt_pk_bf16_f32 %0, %1, %2" : "=v"(r) : "v"(lo), "v"(hi)); return r; }
typedef float f32x2 __attribute__((ext_vector_type(2)));
template <class Epi, class Sched, bool ALIGN_EPI = false, bool SP2 = false>
__device__ __forceinline__ void gemm_phase(PG8_LAS unsigned char* lds, const Gemm g, const Sched& S, const Epi& E) {
    const int tid = threadIdx.x, wid = __builtin_amdgcn_readfirstlane(tid >> 6), lane = tid & 63, wr = wid >> 2, wc = wid & 3, fr = lane & 15, fq = lane >> 4;
    const int K = g.K, nt = K / BK;
    unsigned voffA[2], voffB[2];
#pragma unroll
    for (int i = 0; i < 2; ++i) { int R, C; stage_rc(tid * 16 + i * 8192, R, C); const int Rb = Epi::PERM ? ((R & ~31) + perm32(R & 31)) : R;
        voffA[i] = (unsigned)(R * K + C) * 2u; voffB[i] = (unsigned)(Rb * K + C) * 2u; }
    const size_t kstep = (size_t)(BK * 2);
    const size_t hstep = (size_t)HALF * K * 2;
    const size_t tstep = 2 * hstep;
    const unsigned ldsw = (unsigned)wid * 1024u;
    const int aoff = lds_byte(wr * 64 + fr, fq * 8), boff = lds_byte(wc * 32 + fr, fq * 8);
#define PG8_SA(b, h) (((b) * 2 + (h)) * HTB)
#define PG8_SB(b, h) ((4 + (b) * 2 + (h)) * HTB)
#define PG8_STAGE(bufoff, gbase, voff) do { _Pragma("unroll") for (int _i = 0; _i < 2; ++_i) \
        __builtin_amdgcn_global_load_lds((const unsigned*)((const char*)(gbase) + (voff)[_i]), (PG8_LAS unsigned*)(lds + (bufoff) + ldsw + _i * 8192), 16, 0, 0); } while (0)
#define PG8_LDA(dst, b, h) do { _Pragma("unroll") for (int m = 0; m < 4; ++m) _Pragma("unroll") for (int k = 0; k < 2; ++k) dst[m][k] = *(const PG8_LAS bf16x8*)(lds + PG8_SA(b, h) + aoff + m * 2048 + k * 1024); } while (0)
#define PG8_LDB(dst, b, h) do { _Pragma("unroll") for (int n = 0; n < 2; ++n) _Pragma("unroll") for (int k = 0; k < 2; ++k) dst[n][k] = *(const PG8_LAS bf16x8*)(lds + PG8_SB(b, h) + boff + n * 2048 + k * 1024); } while (0)
#define PG8_MMA(ai, bj, At, Bt) do { __builtin_amdgcn_s_setprio(1); _Pragma("unroll") for (int m = 0; m < 4; ++m) _Pragma("unroll") for (int n = 0; n < 2; ++n) _Pragma("unroll") for (int k = 0; k < 2; ++k) \
        acc[ai][bj][m][n] = __builtin_amdgcn_mfma_f32_16x16x32_bf16(Bt[n][k], At[m][k], acc[ai][bj][m][n], 0, 0, 0); __builtin_amdgcn_s_setprio(0); } while (0)
#define PG8_WAIT_V(n) asm volatile("s_waitcnt vmcnt(" #n ")" ::: "memory")
#define PG8_WAIT_L(n) asm volatile("s_waitcnt lgkmcnt(" #n ")" ::: "memory")
#define PG8_BAR __builtin_amdgcn_s_barrier()
#define PG8_SCHED __builtin_amdgcn_sched_barrier(0)
    Unit cur, nxt; int ui = 0;
    if (!S.next(0, cur)) return;
    f32x4 acc[2][2][4][2];
#pragma unroll
    for (int a = 0; a < 2; ++a)
#pragma unroll
        for (int b = 0; b < 2; ++b)
#pragma unroll
            for (int m = 0; m < 4; ++m)
#pragma unroll
                for (int n = 0; n < 2; ++n) acc[a][b][m][n] = (f32x4){0.f, 0.f, 0.f, 0.f};
    bf16x8 At[4][2], B0[2][2], B1[2][2];
    const char* cA = (const char*)g.A + (size_t)cur.pm * tstep; const char* cB = (const char*)g.Bt + (size_t)cur.pn * tstep;
    S.a_ready(cur);
    if constexpr (SP2) {
        PG8_STAGE(PG8_SB(0, 0), cB, voffB); PG8_STAGE(PG8_SB(0, 1), cB + hstep, voffB); PG8_STAGE(PG8_SA(0, 0), cA, voffA); PG8_STAGE(PG8_SA(0, 1), cA + hstep, voffA);
        if (wr == 1) PG8_BAR;
        PG8_WAIT_V(2); PG8_BAR;
        PG8_STAGE(PG8_SB(1, 0), cB + kstep, voffB); PG8_STAGE(PG8_SA(1, 0), cA + kstep, voffA); PG8_STAGE(PG8_SB(1, 1), cB + hstep + kstep, voffB);
        PG8_WAIT_V(6); PG8_BAR;
    } else {
        PG8_STAGE(PG8_SB(0, 0), cB, voffB); PG8_STAGE(PG8_SA(0, 0), cA, voffA); PG8_STAGE(PG8_SB(0, 1), cB + hstep, voffB); PG8_STAGE(PG8_SA(0, 1), cA + hstep, voffA);
        if (wr == 1) PG8_BAR;
        PG8_WAIT_V(4); PG8_BAR;
        PG8_STAGE(PG8_SB(1, 0), cB + kstep, voffB); PG8_STAGE(PG8_SA(1, 0), cA + kstep, voffA); PG8_STAGE(PG8_SB(1, 1), cB + hstep + kstep, voffB);
        PG8_WAIT_V(6); PG8_BAR;
    }
    for (;;) {
        const bool has_next = S.next(ui + 1, nxt);
        const char* nA = has_next ? (const char*)g.A + (size_t)nxt.pm * tstep : cA; const char* nB = has_next ? (const char*)g.Bt + (size_t)nxt.pn * tstep : cB;
        for (int t = 0; t < nt; t += 2) {
            const bool last = (t == nt - 2);
            const char* a1 = cA + (size_t)(t + 1) * kstep;
            const char* a2 = last ? nA : cA + (size_t)(t + 2) * kstep; const char* b2 = last ? nB : cB + (size_t)(t + 2) * kstep;
            const char* a3 = a2 + kstep; const char* b3 = b2 + kstep;
            if (last && has_next) S.a_ready(nxt);
            if constexpr (SP2) {
            PG8_LDB(B0, 0, 0); PG8_LDB(B1, 0, 1); PG8_SCHED; PG8_LDA(At, 0, 0); PG8_STAGE(PG8_SA(1, 1), a1 + hstep, voffA);
            PG8_WAIT_V(8); PG8_WAIT_L(0); PG8_BAR; PG8_MMA(0, 0, At, B0); PG8_MMA(0, 1, At, B1); PG8_BAR; PG8_SCHED;
            PG8_LDA(At, 0, 1); PG8_STAGE(PG8_SB(0, 0), b2, voffB); PG8_STAGE(PG8_SB(0, 1), b2 + hstep, voffB); PG8_STAGE(PG8_SA(0, 0), a2, voffA);
            PG8_WAIT_V(8); PG8_WAIT_L(0); PG8_BAR; PG8_MMA(1, 0, At, B0); PG8_MMA(1, 1, At, B1); PG8_BAR; PG8_SCHED;
            PG8_LDB(B0, 1, 0); PG8_LDB(B1, 1, 1); PG8_SCHED; PG8_LDA(At, 1, 0); PG8_STAGE(PG8_SA(0, 1), a2 + hstep, voffA);
            PG8_WAIT_V(8); PG8_WAIT_L(0); PG8_BAR; PG8_MMA(0, 0, At, B0); PG8_MMA(0, 1, At, B1); PG8_BAR; PG8_SCHED;
            PG8_LDA(At, 1, 1); PG8_STAGE(PG8_SB(1, 0), b3, voffB); PG8_STAGE(PG8_SB(1, 1), b3 + hstep, voffB); PG8_STAGE(PG8_SA(1, 0), a3, voffA);
            PG8_WAIT_V(8); PG8_WAIT_L(0); PG8_BAR; PG8_MMA(1, 0, At, B0); PG8_MMA(1, 1, At, B1); PG8_BAR; PG8_SCHED;
            } else {
            PG8_LDB(B0, 0, 0); PG8_SCHED; PG8_LDA(At, 0, 0); PG8_STAGE(PG8_SA(1, 1), a1 + hstep, voffA);
            PG8_WAIT_L(8); PG8_BAR; PG8_WAIT_L(0); PG8_MMA(0, 0, At, B0); PG8_BAR; PG8_SCHED;
            PG8_LDB(B1, 0, 1); PG8_STAGE(PG8_SB(0, 0), b2, voffB);
            PG8_BAR; PG8_WAIT_L(0); PG8_MMA(0, 1, At, B1); PG8_BAR;
            PG8_LDA(At, 0, 1); PG8_STAGE(PG8_SA(0, 0), a2, voffA);
            PG8_BAR; PG8_WAIT_L(0); PG8_MMA(1, 0, At, B0); PG8_BAR; PG8_SCHED;
            PG8_STAGE(PG8_SB(0, 1), b2 + hstep, voffB);
            PG8_WAIT_V(6); PG8_BAR; PG8_MMA(1, 1, At, B1); PG8_BAR;
            PG8_LDB(B0, 1, 0); PG8_SCHED; PG8_LDA(At, 1, 0); PG8_STAGE(PG8_SA(0, 1), a2 + hstep, voffA);
            PG8_WAIT_L(8); PG8_BAR; PG8_WAIT_L(0); PG8_MMA(0, 0, At, B0); PG8_BAR; PG8_SCHED;
            PG8_LDB(B1, 1, 1); PG8_STAGE(PG8_SB(1, 0), b3, voffB);
            PG8_BAR; PG8_WAIT_L(0); PG8_MMA(0, 1, At, B1); PG8_BAR;
            PG8_LDA(At, 1, 1); PG8_STAGE(PG8_SA(1, 0), a3, voffA);
            PG8_BAR; PG8_WAIT_L(0); PG8_MMA(1, 0, At, B0); PG8_BAR; PG8_SCHED;
            PG8_STAGE(PG8_SB(1, 1), b3 + hstep, voffB);
            PG8_WAIT_V(6); PG8_BAR; PG8_MMA(1, 1, At, B1); PG8_BAR;
            }
        }
        if constexpr (ALIGN_EPI) { if (wr == 0) PG8_BAR; }
        if constexpr (!Epi::AFTER_DRAIN) { E(acc, cur, wr, wc, fr, fq); S.done(cur); }
        if (!has_next) break;
#pragma unroll
        for (int a = 0; a < 2; ++a)
#pragma unroll
            for (int b = 0; b < 2; ++b)
#pragma unroll
                for (int m = 0; m < 4; ++m)
#pragma unroll
                    for (int n = 0; n < 2; ++n) acc[a][b][m][n] = (f32x4){0.f, 0.f, 0.f, 0.f};
        cur = nxt; cA = nA; cB = nB; ++ui;
        if constexpr (ALIGN_EPI) { if (wr == 1) PG8_BAR; }
    }
    PG8_WAIT_V(0);
    if constexpr (!ALIGN_EPI) { if (wr == 0) PG8_BAR; }
    PG8_BAR;
    if constexpr (Epi::AFTER_DRAIN) { E.fused(acc, cur, wr, wc, fr, fq, lds, wid, lane); S.done(cur); }
#undef PG8_SA
#undef PG8_SB
#undef PG8_STAGE
#undef PG8_LDA
#undef PG8_LDB
#undef PG8_MMA
#undef PG8_WAIT_V
#undef PG8_WAIT_L
#undef PG8_BAR
#undef PG8_SCHED
}
}

#ifndef PROBE
#define PROBE 0
#endif
#ifndef MK_PER_PHASE
#define MK_PER_PHASE 0
#endif
#ifndef TS_K
#define TS_K -1
#endif
constexpr int BATCH = 8, SEQ = 2048, D = 1024, M = BATCH * SEQ, DFF = 2816, NGU = 2 * DFF, NIN = 5632;
constexpr float EPS = 1e-6f, LOG2E = 1.4426950408889634f;
constexpr float QSCALE = 0.125f * LOG2E;
constexpr int NWAVES = 8, NTHREADS = 512;
constexpr int LDS_BYTES = 147456;

constexpr size_t MiB = 1u << 20;
constexpr size_t WS_WGU = 0, WS_WD = 11 * MiB, WS_WIN = 17 * MiB, WS_WPL = 28 * MiB, WS_WPA = 30 * MiB, WS_WOUT = 32 * MiB, WS_ROPE = 34 * MiB;
constexpr size_t WS_XN = 36 * MiB;
constexpr size_t WS_GB = 68 * MiB, WS_XB = 100 * MiB, WS_Q = 132 * MiB, WS_K = 164 * MiB, WS_V = 172 * MiB, WS_GL = 180 * MiB, WS_GA = 212 * MiB;
constexpr size_t WS_ACT = 68 * MiB;
constexpr size_t WS_F = 180 * MiB;
constexpr size_t WS_MB = WS_XB;
constexpr size_t WS_END = 244 * MiB;

#define LAS __attribute__((address_space(3)))
typedef unsigned short bf16;
typedef unsigned u32x4 __attribute__((ext_vector_type(4)));
typedef unsigned u32x2 __attribute__((ext_vector_type(2)));
typedef float f32x4 __attribute__((ext_vector_type(4)));
typedef float f32x2 __attribute__((ext_vector_type(2)));
typedef float f32x16 __attribute__((ext_vector_type(16)));
typedef short bf16x8 __attribute__((ext_vector_type(8)));

__device__ __forceinline__ unsigned pk2(float lo, float hi) { return pg8::cvt_pk_bf16(lo, hi); }
__device__ __forceinline__ float bflo(unsigned w) { return __uint_as_float(w << 16); }
__device__ __forceinline__ float bfhi(unsigned w) { return __uint_as_float(w & 0xffff0000u); }
__device__ __forceinline__ float bf2f(bf16 v) { return __uint_as_float((unsigned)v << 16); }
__device__ __forceinline__ float sigmoidf_(float x) { return __builtin_amdgcn_rcpf(1.f + __builtin_amdgcn_exp2f(-x * LOG2E)); }
__device__ __forceinline__ float siluf_(float x) { return x * sigmoidf_(x); }
__device__ __forceinline__ float gelu_tanh_(float x) { const float y = 0.7978845608028654f * (x + 0.044715f * x * x * x); return x * sigmoidf_(2.f * y); }
__device__ __forceinline__ float act_(float v, int act) { return act == 1 ? gelu_tanh_(v) : (act == 2 ? sigmoidf_(v) : v); }
__device__ __forceinline__ float wave_sum(float v) {
#pragma unroll
    for (int o = 1; o < 64; o <<= 1) v += __shfl_xor(v, o);
    return v;
}

namespace pg8 {
struct EpiSwiglu {
    static constexpr bool PERM = true, AFTER_DRAIN = false;
    bf16_t* O;
    __device__ __forceinline__ void operator()(const f32x4 (&acc)[2][2][4][2], const Unit& u, int wr, int wc, int fr, int fq) const {
        const int row0 = u.pm * BM + wr * 64 + fr, col0 = u.pn * 128 + wc * 32 + 8 * fq;
#pragma unroll
        for (int ai = 0; ai < 2; ++ai)
#pragma unroll
            for (int m = 0; m < 4; ++m) {
                bf16_t* p = O + (size_t)(row0 + ai * HALF + m * 16) * DFF + col0;
                const f32x4 g0 = acc[ai][0][m][0], g1 = acc[ai][0][m][1], u0 = acc[ai][1][m][0], u1 = acc[ai][1][m][1];
                u32x4 w;
                w.x = cvt_pk_bf16(siluf_(g0[0]) * u0[0], siluf_(g0[1]) * u0[1]); w.y = cvt_pk_bf16(siluf_(g0[2]) * u0[2], siluf_(g0[3]) * u0[3]);
                w.z = cvt_pk_bf16(siluf_(g1[0]) * u1[0], siluf_(g1[1]) * u1[1]); w.w = cvt_pk_bf16(siluf_(g1[2]) * u1[2], siluf_(g1[3]) * u1[3]);
                *(u32x4*)p = w;
            }
    }
};
struct EpiBf {
    static constexpr bool PERM = true, AFTER_DRAIN = false;
    bf16_t* O; int ldc;
    __device__ __forceinline__ void operator()(const f32x4 (&acc)[2][2][4][2], const Unit& u, int wr, int wc, int fr, int fq) const {
        const int row0 = u.pm * BM + wr * 64 + fr, col0 = u.pn * BM + wc * 32 + 8 * fq;
#pragma unroll
        for (int ai = 0; ai < 2; ++ai)
#pragma unroll
            for (int m = 0; m < 4; ++m) {
                bf16_t* p = O + (size_t)(row0 + ai * HALF + m * 16) * ldc + col0;
#pragma unroll
                for (int bj = 0; bj < 2; ++bj) {
                    const f32x4 v0 = acc[ai][bj][m][0], v1 = acc[ai][bj][m][1];
                    u32x4 w; w.x = cvt_pk_bf16(v0[0], v0[1]); w.y = cvt_pk_bf16(v0[2], v0[3]); w.z = cvt_pk_bf16(v1[0], v1[1]); w.w = cvt_pk_bf16(v1[2], v1[3]);
                    *(u32x4*)(p + bj * HALF) = w;
                }
            }
    }
};
struct EpiMix {
    static constexpr bool PERM = true, AFTER_DRAIN = false;
    bf16_t *GB, *XB, *Q, *K, *V, *GL, *GA; const float* rope;
    __device__ __forceinline__ void operator()(const f32x4 (&acc)[2][2][4][2], const Unit& u, int wr, int wc, int fr, int fq) const {
        const int pn = u.pn, row0 = u.pm * BM + wr * 64 + fr;
        if (pn >= 8 && pn <= 12) {
            const bool isq = pn < 12; bf16_t* base = isq ? Q + 256 * (pn - 8) : K; const int ld = isq ? D : 256; const float sc = isq ? QSCALE : 1.f;
            const int dd0 = 8 * fq, col = 64 * wc + dd0;
#pragma unroll
            for (int ai = 0; ai < 2; ++ai)
#pragma unroll
                for (int m = 0; m < 4; ++m) {
                    const int row = row0 + ai * HALF + m * 16, pos = row & (SEQ - 1);
                    const f32x4* tp = (const f32x4*)(rope + (size_t)(pos * 32 + dd0) * 2);
                    const f32x4 t0 = tp[0], t1 = tp[1], t2 = tp[2], t3 = tp[3];
                    const f32x4 xa = acc[ai][0][m][0], xb = acc[ai][0][m][1], ya = acc[ai][1][m][0], yb = acc[ai][1][m][1];
                    float c[8] = {t0[0], t0[2], t1[0], t1[2], t2[0], t2[2], t3[0], t3[2]};
                    float s[8] = {t0[1], t0[3], t1[1], t1[3], t2[1], t2[3], t3[1], t3[3]};
                    float x1[8] = {xa[0], xa[1], xa[2], xa[3], xb[0], xb[1], xb[2], xb[3]};
                    float x2[8] = {ya[0], ya[1], ya[2], ya[3], yb[0], yb[1], yb[2], yb[3]};
                    float o1[8], o2[8];
#pragma unroll
                    for (int j = 0; j < 8; ++j) { o1[j] = (x1[j] * c[j] - x2[j] * s[j]) * sc; o2[j] = (x2[j] * c[j] + x1[j] * s[j]) * sc; }
                    u32x4 w1, w2;
                    w1.x = cvt_pk_bf16(o1[0], o1[1]); w1.y = cvt_pk_bf16(o1[2], o1[3]); w1.z = cvt_pk_bf16(o1[4], o1[5]); w1.w = cvt_pk_bf16(o1[6], o1[7]);
                    w2.x = cvt_pk_bf16(o2[0], o2[1]); w2.y = cvt_pk_bf16(o2[2], o2[3]); w2.z = cvt_pk_bf16(o2[4], o2[5]); w2.w = cvt_pk_bf16(o2[6], o2[7]);
                    bf16_t* p = base + (size_t)row * ld + col;
                    *(u32x4*)p = w1; *(u32x4*)(p + 32) = w2;
                }
        } else {
            bf16_t* base; int ld = D, act = 0;
            if (pn < 4) { base = GB + 256 * pn; act = 1; }
            else if (pn < 8) { base = XB + 256 * (pn - 4); }
            else if (pn == 13) { base = V; ld = 256; }
            else if (pn < 18) { base = GL + 256 * (pn - 14); act = 2; }
            else { base = GA + 256 * (pn - 18); act = 2; }
            const int col0 = wc * 32 + 8 * fq;
#pragma unroll
            for (int ai = 0; ai < 2; ++ai)
#pragma unroll
                for (int m = 0; m < 4; ++m) {
                    bf16_t* p = base + (size_t)(row0 + ai * HALF + m * 16) * ld + col0;
#pragma unroll
                    for (int bj = 0; bj < 2; ++bj) {
                        const f32x4 v0 = acc[ai][bj][m][0], v1 = acc[ai][bj][m][1];
                        u32x4 w;
                        w.x = cvt_pk_bf16(act_(v0[0], act), act_(v0[1], act)); w.y = cvt_pk_bf16(act_(v0[2], act), act_(v0[3], act));
                        w.z = cvt_pk_bf16(act_(v1[0], act), act_(v1[1], act)); w.w = cvt_pk_bf16(act_(v1[2], act), act_(v1[3], act));
                        *(u32x4*)(p + bj * HALF) = w;
                    }
                }
        }
    }
};
template <bool SECOND> struct EpiGate {
    static constexpr bool PERM = true, AFTER_DRAIN = false;
    const bf16_t* G; bf16_t* MB;
    __device__ __forceinline__ void operator()(const f32x4 (&acc)[2][2][4][2], const Unit& u, int wr, int wc, int fr, int fq) const {
        const int row0 = u.pm * BM + wr * 64 + fr, col0 = u.pn * BM + wc * 32 + 8 * fq;
#pragma unroll
        for (int ai = 0; ai < 2; ++ai)
#pragma unroll
            for (int m = 0; m < 4; ++m)
#pragma unroll
                for (int bj = 0; bj < 2; ++bj) {
                    const size_t off = (size_t)(row0 + ai * HALF + m * 16) * D + col0 + bj * HALF;
                    const u32x4 g = *(const u32x4*)(G + off);
                    const f32x4 v0 = acc[ai][bj][m][0], v1 = acc[ai][bj][m][1];
                    float o[8] = {bflo(g.x) * v0[0], bfhi(g.x) * v0[1], bflo(g.y) * v0[2], bfhi(g.y) * v0[3], bflo(g.z) * v1[0], bfhi(g.z) * v1[1], bflo(g.w) * v1[2], bfhi(g.w) * v1[3]};
                    if (SECOND) { const u32x4 t = *(const u32x4*)(MB + off);
                        o[0] += bflo(t.x); o[1] += bfhi(t.x); o[2] += bflo(t.y); o[3] += bfhi(t.y); o[4] += bflo(t.z); o[5] += bfhi(t.z); o[6] += bflo(t.w); o[7] += bfhi(t.w); }
                    u32x4 w; w.x = cvt_pk_bf16(o[0], o[1]); w.y = cvt_pk_bf16(o[2], o[3]); w.z = cvt_pk_bf16(o[4], o[5]); w.w = cvt_pk_bf16(o[6], o[7]);
                    *(u32x4*)(MB + off) = w;
                }
    }
};
}

__constant__ float INV_FREQ[32] = {1.000000000e+00f, 7.498942614e-01f, 5.623413324e-01f, 4.216965139e-01f, 3.162277639e-01f, 2.371373773e-01f, 1.778279394e-01f, 1.333521307e-01f,
    1.000000015e-01f, 7.498941571e-02f, 5.623413250e-02f, 4.216965288e-02f, 3.162277490e-02f, 2.371373773e-02f, 1.778279431e-02f, 1.333521493e-02f,
    9.999999776e-03f, 7.498941850e-03f, 5.623413250e-03f, 4.216964822e-03f, 3.162277630e-03f, 2.371373586e-03f, 1.778279431e-03f, 1.333521446e-03f,
    1.000000047e-03f, 7.498942432e-04f, 5.623413017e-04f, 4.216965172e-04f, 3.162277571e-04f, 2.371373703e-04f, 1.778279402e-04f, 1.333521504e-04f};

__device__ __forceinline__ int dest_row(int mode, int n0) {
    if (mode == 1) { if (n0 < DFF) return 256 * (n0 / 128) + (n0 % 128); const int n1 = n0 - DFF; return 256 * (n1 / 128) + 128 + (n1 % 128); }
    if (mode == 2) { const int tile = n0 >> 8; if (tile >= 8 && tile <= 12) { const int c = n0 & 255, hit = c >> 6, half = (c >> 5) & 1; return (tile << 8) + 128 * half + 32 * hit; } return n0; }
    return n0;
}
__device__ __forceinline__ void transpose_item(const float* W, int K, int N, bf16* WT, int mode, LAS float* scr, int item, int lane) {
    const int nblk = N / 32, kb = item / nblk, nb = item % nblk, k0 = 64 * kb, n0 = 32 * nb;
#pragma unroll
    for (int i = 0; i < 8; ++i) { const int kk = 8 * i + (lane >> 3), c4 = lane & 7;
        const f32x4 v = *(const f32x4*)(W + (size_t)(k0 + kk) * N + n0 + 4 * c4);
        LAS float* d = scr + kk * 33 + 4 * c4; d[0] = v.x; d[1] = v.y; d[2] = v.z; d[3] = v.w; }
    asm volatile("s_waitcnt lgkmcnt(0)" ::: "memory");
    const int c = lane & 7, dr = dest_row(mode, n0);
#pragma unroll
    for (int j = 0; j < 4; ++j) { const int n = (lane >> 3) + 8 * j; const LAS float* s = scr + (8 * c) * 33 + n;
        u32x4 o; o.x = pk2(s[0 * 33], s[1 * 33]); o.y = pk2(s[2 * 33], s[3 * 33]); o.z = pk2(s[4 * 33], s[5 * 33]); o.w = pk2(s[6 * 33], s[7 * 33]);
        *(u32x4*)(WT + (size_t)(dr + n) * K + k0 + 8 * c) = o; }
    asm volatile("s_waitcnt lgkmcnt(0)" ::: "memory");
}
__device__ __forceinline__ void norm_rows(const float* X, const float* g, bf16* XN, int gw, int NGW, int lane) {
    f32x4 gv[4];
#pragma unroll
    for (int j = 0; j < 4; ++j) gv[j] = *((const f32x4*)g + lane + 64 * j);
    for (int m = gw; m < M; m += NGW) {
        const f32x4* xr = (const f32x4*)(X + (size_t)m * D) + lane;
        f32x4 v[4]; float s = 0.f;
#pragma unroll
        for (int j = 0; j < 4; ++j) { v[j] = xr[64 * j]; s += (v[j].x * v[j].x + v[j].y * v[j].y) + (v[j].z * v[j].z + v[j].w * v[j].w); }
        const float r = 1.0f / sqrtf(wave_sum(s) * (1.f / D) + EPS);
        u32x2* o = (u32x2*)(XN + (size_t)m * D) + lane;
#pragma unroll
        for (int j = 0; j < 4; ++j) { u32x2 w; w.x = pk2(v[j].x * r * gv[j].x, v[j].y * r * gv[j].y); w.y = pk2(v[j].z * r * gv[j].z, v[j].w * r * gv[j].w); o[64 * j] = w; }
    }
}
__device__ __forceinline__ void resid_rows(const bf16* F, const float* base, float* H, bf16* XN, const float* gpost, const float* gnext, float scale, int gw, int NGW, int lane) {
    for (int m = gw; m < M; m += NGW) {
        const u32x2* fr = (const u32x2*)(F + (size_t)m * D) + lane;
        const f32x4* br = (const f32x4*)(base + (size_t)m * D) + lane;
        f32x4 f[4], h[4]; float s = 0.f;
#pragma unroll
        for (int j = 0; j < 4; ++j) { const u32x2 fw = fr[64 * j]; f[j] = (f32x4){bflo(fw.x), bfhi(fw.x), bflo(fw.y), bfhi(fw.y)}; h[j] = br[64 * j]; s += (f[j].x * f[j].x + f[j].y * f[j].y) + (f[j].z * f[j].z + f[j].w * f[j].w); }
        const float r = scale / sqrtf(wave_sum(s) * (1.f / D) + EPS);
        float s2 = 0.f;
        f32x4* ho = (f32x4*)(H + (size_t)m * D) + lane;
#pragma unroll
        for (int j = 0; j < 4; ++j) { const f32x4 g = *((const f32x4*)gpost + lane + 64 * j); h[j] = h[j] + f[j] * r * g; ho[64 * j] = h[j];
            s2 += (h[j].x * h[j].x + h[j].y * h[j].y) + (h[j].z * h[j].z + h[j].w * h[j].w); }
        if (XN) {
            const float r2 = 1.0f / sqrtf(wave_sum(s2) * (1.f / D) + EPS);
            u32x2* o = (u32x2*)(XN + (size_t)m * D) + lane;
#pragma unroll
            for (int j = 0; j < 4; ++j) { const f32x4 g = *((const f32x4*)gnext + lane + 64 * j);
                u32x2 w; w.x = pk2(h[j].x * r2 * g.x, h[j].y * r2 * g.y); w.y = pk2(h[j].z * r2 * g.z, h[j].w * r2 * g.w); o[64 * j] = w; }
        }
    }
}
__device__ __forceinline__ void rope_entry(int idx, float* tab) {
    const int pos = idx >> 5, d = idx & 31;
    const float ang = (float)pos * INV_FREQ[d];
    const double x = (double)ang;
    const double k = __builtin_rint(x * 0.63661977236758134308);
    const double r = __builtin_fma(-k, 1.57079632679489661923, x) - k * 6.123233995736766e-17;
    const double r2 = r * r;
    double sp = -1.0 / 39916800.0; sp = sp * r2 + 1.0 / 362880.0; sp = sp * r2 - 1.0 / 5040.0; sp = sp * r2 + 1.0 / 120.0; sp = sp * r2 - 1.0 / 6.0; sp = sp * r2 * r + r;
    double cp = 1.0 / 479001600.0; cp = cp * r2 - 1.0 / 3628800.0; cp = cp * r2 + 1.0 / 40320.0; cp = cp * r2 - 1.0 / 720.0; cp = cp * r2 + 1.0 / 24.0; cp = cp * r2 - 0.5; cp = cp * r2 + 1.0;
    const int q = ((int)k) & 3;
    const double c = (q == 0) ? cp : (q == 1) ? -sp : (q == 2) ? -cp : sp;
    const double s = (q == 0) ? sp : (q == 1) ? cp : (q == 2) ? -sp : -cp;
    tab[2 * idx] = (float)c; tab[2 * idx + 1] = (float)s;
}

constexpr int RL_XS = 0, RL_XC = 33280, RL_A = 70144, RL_B = 102912, RL_SA = 135680, RL_SH = 137728, RL_CARRY = 139776, RL_CW = 140032;
__device__ __forceinline__ void rec_unit(LAS unsigned char* lds, int unit, const bf16* XB, const bf16* GB, bf16* YO, const float* conv_w, const float* conv_b,
                                         const float* w_a, const float* b_a, const float* w_x, const float* b_x, const float* lam) {
    const int tid = threadIdx.x, lane = tid & 63, wid = tid >> 6, r32 = lane & 31, hi = lane >> 5;
    const int b = unit >> 5, n = (unit >> 1) & 15, half = unit & 1;
    LAS bf16* XS = (LAS bf16*)(lds + RL_XS);
    LAS bf16* XC = (LAS bf16*)(lds + RL_XC);
    LAS float* A32 = (LAS float*)(lds + RL_A);
    LAS float* B32 = (LAS float*)(lds + RL_B);
    LAS float* SA = (LAS float*)(lds + RL_SA);
    LAS float* SH = (LAS float*)(lds + RL_SH);
    LAS float* CARRY = (LAS float*)(lds + RL_CARRY);
    LAS float* CW = (LAS float*)(lds + RL_CW);
    if (tid < 256) CW[tid] = conv_w[(size_t)(tid >> 6) * D + n * 64 + (tid & 63)];
    else if (tid < 320) CW[tid] = conv_b[n * 64 + (tid & 63)];
    if (tid < 32) CARRY[tid] = 0.f;
    const int ch = n * 64 + half * 32 + r32;
    const float ba = b_a[ch], bx = b_x[ch];
    const float sp = log1pf(__expf(-lam[ch]));
    bf16x8 wa[4], wx[4];
#pragma unroll
    for (int ks = 0; ks < 4; ++ks)
#pragma unroll
        for (int j = 0; j < 8; ++j) {
            const size_t wi = ((size_t)n * 64 + 16 * ks + 8 * hi + j) * 64 + half * 32 + r32;
            wa[ks][j] = (short)(pk2(w_a[wi], 0.f) & 0xffffu); wx[ks][j] = (short)(pk2(w_x[wi], 0.f) & 0xffffu);
        }
    const size_t tokbase = (size_t)b * SEQ;
    const bf16* xsrc = XB + n * 64 + 8 * (tid & 7);
    u32x4 pre[5];
#pragma unroll
    for (int it = 0; it < 5; ++it) { const int i = (tid >> 3) + 64 * it, t = i - 3; pre[it] = (u32x4){0u, 0u, 0u, 0u};
        if (i < 259 && t >= 0) pre[it] = *(const u32x4*)(xsrc + (tokbase + t) * D); }
    for (int k = 0; k < SEQ / 256; ++k) {
        const int t0 = 256 * k;
#pragma unroll
        for (int it = 0; it < 5; ++it) { const int i = (tid >> 3) + 64 * it; if (i < 259) *(LAS u32x4*)(XS + i * 64 + 8 * (tid & 7)) = pre[it]; }
        __syncthreads();
        if (k + 1 < SEQ / 256) {
#pragma unroll
            for (int it = 0; it < 5; ++it) { const int i = (tid >> 3) + 64 * it, t = t0 + 256 + i - 3; if (i < 259) pre[it] = *(const u32x4*)(xsrc + (tokbase + t) * D); }
        }
#pragma unroll
        for (int it = 0; it < 4; ++it) {
            const int id = tid + 512 * it, g8 = id & 7, tt = id >> 3;
            float o[8];
            { const f32x4 c0 = *(const LAS f32x4*)(CW + 256 + 8 * g8), c1 = *(const LAS f32x4*)(CW + 256 + 8 * g8 + 4);
              o[0] = c0[0]; o[1] = c0[1]; o[2] = c0[2]; o[3] = c0[3]; o[4] = c1[0]; o[5] = c1[1]; o[6] = c1[2]; o[7] = c1[3]; }
#pragma unroll
            for (int tap = 0; tap < 4; ++tap) {
                const u32x4 xv = *(const LAS u32x4*)(XS + (tt + tap) * 64 + 8 * g8);
                const f32x4 c0 = *(const LAS f32x4*)(CW + 64 * tap + 8 * g8), c1 = *(const LAS f32x4*)(CW + 64 * tap + 8 * g8 + 4);
                o[0] += c0[0] * bflo(xv.x); o[1] += c0[1] * bfhi(xv.x); o[2] += c0[2] * bflo(xv.y); o[3] += c0[3] * bfhi(xv.y);
                o[4] += c1[0] * bflo(xv.z); o[5] += c1[1] * bfhi(xv.z); o[6] += c1[2] * bflo(xv.w); o[7] += c1[3] * bfhi(xv.w);
            }
            u32x4 w; w.x = pk2(o[0], o[1]); w.y = pk2(o[2], o[3]); w.z = pk2(o[4], o[5]); w.w = pk2(o[6], o[7]);
            *(LAS u32x4*)(XC + tt * 72 + 8 * g8) = w;
        }
        __syncthreads();
        f32x16 aa, ax;
#pragma unroll
        for (int i = 0; i < 16; ++i) { aa[i] = 0.f; ax[i] = 0.f; }
#pragma unroll
        for (int ks = 0; ks < 4; ++ks) {
            const bf16x8 af = *(const LAS bf16x8*)(XC + (32 * wid + r32) * 72 + 16 * ks + 8 * hi);
            aa = __builtin_amdgcn_mfma_f32_32x32x16_bf16(af, wa[ks], aa, 0, 0, 0);
            ax = __builtin_amdgcn_mfma_f32_32x32x16_bf16(af, wx[ks], ax, 0, 0, 0);
        }
#pragma unroll
        for (int i = 0; i < 16; ++i) {
            const int tok = 32 * wid + (i & 3) + 8 * (i >> 2) + 4 * hi;
            const float ra = sigmoidf_(aa[i] + ba), ii = sigmoidf_(ax[i] + bx);
            const float la = -8.0f * ra * sp;
            const float a = __builtin_amdgcn_exp2f(la * LOG2E);
            const float mult = __builtin_amdgcn_sqrtf(fmaxf(__builtin_fmaf(-a, a, 1.0f), 0.f));
            const float xcv = bf2f(XC[tok * 72 + half * 32 + r32]);
            A32[tok * 32 + r32] = a; B32[tok * 32 + r32] = mult * ii * xcv;
        }
        __syncthreads();
        const int c = tid & 31, seg = tid >> 5;
        const size_t goff = (tokbase + t0 + 16 * seg) * D + n * 64 + half * 32 + c;
        const bf16* gptr = GB + goff; bf16* yptr = YO + goff;
        bf16 gate[16];
#pragma unroll
        for (int j = 0; j < 16; ++j) gate[j] = gptr[(size_t)j * D];
        {
            float Aacc = 1.f, Hh = 0.f;
#pragma unroll
            for (int j = 0; j < 16; ++j) { const float a = A32[(16 * seg + j) * 32 + c], bb = B32[(16 * seg + j) * 32 + c]; Hh = a * Hh + bb; Aacc *= a; }
            SA[seg * 32 + c] = Aacc; SH[seg * 32 + c] = Hh;
        }
        __syncthreads();
        {
            float h = CARRY[(k & 1) * 32 + c];
            for (int s = 0; s < seg; ++s) h = SA[s * 32 + c] * h + SH[s * 32 + c];
#pragma unroll
            for (int j = 0; j < 16; ++j) { const float a = A32[(16 * seg + j) * 32 + c], bb = B32[(16 * seg + j) * 32 + c]; h = a * h + bb;
                yptr[(size_t)j * D] = (bf16)(pk2(h * bf2f(gate[j]), 0.f) & 0xffffu); }
            if (seg == 15) CARRY[((k + 1) & 1) * 32 + c] = h;
        }
    }
    __syncthreads();
}

constexpr int AT_KS = 0, AT_VT = 36864;
__device__ __forceinline__ void attn_unit(LAS unsigned char* lds, int unit, const bf16* Q, bf16* YO, const bf16* K, const bf16* V, const float* sinks) {
    const int tid = threadIdx.x, lane = tid & 63, wid = tid >> 6, r32 = lane & 31, hi = lane >> 5;
    const int b = unit >> 6, nb = (unit >> 2) & 15, kvh = unit & 3;
    LAS bf16* KS = (LAS bf16*)(lds + AT_KS);
    LAS bf16* VT = (LAS bf16*)(lds + AT_VT);
    const long rowq0 = (long)b * SEQ + nb * 128, rowk0 = rowq0 - 128;
#pragma unroll
    for (int it = 0; it < 4; ++it) {
        const int key = (tid >> 3) + 64 * it, cch = tid & 7;
        u32x4 kv = (u32x4){0u, 0u, 0u, 0u}, vv = (u32x4){0u, 0u, 0u, 0u};
        if (nb > 0 || key >= 128) { kv = *(const u32x4*)(K + (rowk0 + key) * 256 + kvh * 64 + 8 * cch); vv = *(const u32x4*)(V + (rowk0 + key) * 256 + kvh * 64 + 8 * cch); }
        *(LAS u32x4*)(KS + key * 72 + 8 * cch) = kv;
        const int pp = (key & ~15) + 8 * ((key >> 2) & 1) + 4 * ((key >> 3) & 1) + (key & 3);
        LAS bf16* vp = VT + (8 * cch) * 264 + pp;
        vp[0 * 264] = (bf16)(vv.x & 0xffffu); vp[1 * 264] = (bf16)(vv.x >> 16); vp[2 * 264] = (bf16)(vv.y & 0xffffu); vp[3 * 264] = (bf16)(vv.y >> 16);
        vp[4 * 264] = (bf16)(vv.z & 0xffffu); vp[5 * 264] = (bf16)(vv.z >> 16); vp[6 * 264] = (bf16)(vv.w & 0xffffu); vp[7 * 264] = (bf16)(vv.w >> 16);
    }
    const int g = wid >> 1, qh = wid & 1, hq = kvh * 4 + g;
    const size_t qoff = (size_t)(rowq0 + 64 * qh + r32) * D + hq * 64;
    const bf16* qbase = Q + qoff; bf16* obase = YO + qoff;
    bf16x8 qf[2][4];
#pragma unroll
    for (int qi = 0; qi < 2; ++qi)
#pragma unroll
        for (int ks = 0; ks < 4; ++ks) qf[qi][ks] = *(const bf16x8*)(qbase + (size_t)(32 * qi) * D + 16 * ks + 8 * hi);
    const float sink2 = sinks[hq] * LOG2E;
    __syncthreads();
#pragma unroll
    for (int qi = 0; qi < 2; ++qi) {
        const int kt0 = 2 * qh + qi;
        f32x16 s[5];
#pragma unroll
        for (int j = 0; j < 5; ++j) {
#pragma unroll
            for (int i = 0; i < 16; ++i) s[j][i] = 0.f;
#pragma unroll
            for (int ks = 0; ks < 4; ++ks) {
                const bf16x8 kf = *(const LAS bf16x8*)(KS + (32 * (kt0 + j) + r32) * 72 + 16 * ks + 8 * hi);
                s[j] = __builtin_amdgcn_mfma_f32_32x32x16_bf16(kf, qf[qi][ks], s[j], 0, 0, 0);
            }
        }
        float mx = sink2;
#pragma unroll
        for (int j = 0; j < 5; ++j) {
            const bool tile_ok = (nb > 0) || (kt0 + j >= 4);
#pragma unroll
            for (int i = 0; i < 16; ++i) {
                const int kk = (i & 3) + 8 * (i >> 2) + 4 * hi;
                bool ok = tile_ok;
                if (j == 0) ok = ok && (kk > r32);
                if (j == 4) ok = ok && (kk <= r32);
                s[j][i] = ok ? s[j][i] : -1e30f;
                mx = fmaxf(mx, s[j][i]);
            }
        }
        mx = fmaxf(mx, __shfl_xor(mx, 32));
        float l = 0.f;
#pragma unroll
        for (int j = 0; j < 5; ++j)
#pragma unroll
            for (int i = 0; i < 16; ++i) { const float p = __builtin_amdgcn_exp2f(s[j][i] - mx); s[j][i] = p; l += p; }
        l += __shfl_xor(l, 32);
        l += __builtin_amdgcn_exp2f(sink2 - mx);
        f32x16 o[2];
#pragma unroll
        for (int i = 0; i < 16; ++i) { o[0][i] = 0.f; o[1][i] = 0.f; }
#pragma unroll
        for (int j = 0; j < 5; ++j)
#pragma unroll
            for (int s2 = 0; s2 < 2; ++s2) {
                u32x4 pw; pw.x = pk2(s[j][8 * s2 + 0], s[j][8 * s2 + 1]); pw.y = pk2(s[j][8 * s2 + 2], s[j][8 * s2 + 3]); pw.z = pk2(s[j][8 * s2 + 4], s[j][8 * s2 + 5]); pw.w = pk2(s[j][8 * s2 + 6], s[j][8 * s2 + 7]);
                const bf16x8 pf = __builtin_bit_cast(bf16x8, pw);
#pragma unroll
                for (int db = 0; db < 2; ++db) {
                    const bf16x8 vf = *(const LAS bf16x8*)(VT + (32 * db + r32) * 264 + 32 * (kt0 + j) + 16 * s2 + 8 * hi);
                    o[db] = __builtin_amdgcn_mfma_f32_32x32x16_bf16(vf, pf, o[db], 0, 0, 0);
                }
            }
        const float inv = 1.0f / l;
        bf16* op = obase + (size_t)(32 * qi) * D;
#pragma unroll
        for (int db = 0; db < 2; ++db)
#pragma unroll
            for (int i4 = 0; i4 < 4; ++i4) {
                u32x2 w; w.x = pk2(o[db][4 * i4 + 0] * inv, o[db][4 * i4 + 1] * inv); w.y = pk2(o[db][4 * i4 + 2] * inv, o[db][4 * i4 + 3] * inv);
                *(u32x2*)(op + 32 * db + 8 * i4 + 4 * hi) = w;
            }
    }
    __syncthreads();
}

constexpr size_t WS_CTL = 244 * MiB; constexpr size_t CTL_BYTES = 16384; constexpr int MISC_OFF = LDS_BYTES - 64;
#define XB_TMO      128
#define XB_XCNT(j)  (256  + 64 * (j))
#define XB_XSUB(j)  (1280 + 64 * (j))
#define XB_XGEN(j)  (2304 + 64 * (j))
#define XB_TOP      3328
#define XB_TOPGEN   3392
#define XCD_BAR_WORDS 3456
#define XB_SPIN_CAP (1u << 18)

__device__ __forceinline__ unsigned xb_ld(unsigned* p)              { return __hip_atomic_load(p, __ATOMIC_RELAXED, __HIP_MEMORY_SCOPE_AGENT); }
__device__ __forceinline__ unsigned xb_add(unsigned* p, unsigned v) { return __hip_atomic_fetch_add(p, v, __ATOMIC_RELAXED, __HIP_MEMORY_SCOPE_AGENT); }
__device__ __forceinline__ unsigned xb_xcc_id() { return (unsigned)__builtin_amdgcn_s_getreg((3 << 11) | 20) & 0xFu; }
#define XB_SPIN(cond, bar) do { unsigned _sp = 0; while (cond) { __builtin_amdgcn_s_sleep(1); \
    if ((++_sp & 255u) == 0u) { if (xb_ld(&(bar)[XB_TMO])) break; if (_sp > XB_SPIN_CAP) { atomicAdd(&(bar)[XB_TMO], 1u); break; } } } } while (0)

struct XcdBarrier {
    unsigned* bar; unsigned x;
    volatile LAS unsigned* st;
};

__device__ __forceinline__ XcdBarrier xcd_barrier_post(unsigned* bar, volatile LAS unsigned* st) {
    XcdBarrier b; b.bar = bar; b.x = xb_xcc_id(); b.st = st;
    if (threadIdx.x == 0) (void)xb_add(&bar[XB_XCNT(b.x)], 1u);
    return b;
}
__device__ __forceinline__ void xcd_barrier_complete(unsigned* bar, unsigned x, unsigned& nloc, unsigned& nx) {
    const unsigned G = gridDim.x * gridDim.y * gridDim.z;
    unsigned sum, cnt, mine, sp = 0u;
    for (;;) {
        sum = 0u; cnt = 0u; mine = 0u;
#pragma unroll
        for (unsigned j = 0; j < 16; ++j) { const unsigned c = xb_ld(&bar[XB_XCNT(j)]); sum += c; cnt += (c > 0u) ? 1u : 0u; mine = (j == x) ? c : mine; }
        if (sum == G) break;
        __builtin_amdgcn_s_sleep(1);
        if ((++sp & 255u) == 0u) { if (xb_ld(&bar[XB_TMO])) break; if (sp > XB_SPIN_CAP) { atomicAdd(&bar[XB_TMO], 1u); break; } }
    }
    nloc = mine > 0u ? mine : 1u; nx = cnt > 0u ? cnt : 1u;
}

__device__ __forceinline__ void xcd_barrier(const XcdBarrier& b) {
    asm volatile("s_waitcnt vmcnt(0)" ::: "memory");
    __syncthreads();
    if (threadIdx.x == 0) {
        unsigned* bar = b.bar;
        __builtin_amdgcn_s_waitcnt(0);
        unsigned nloc = b.st[0], nx = b.st[1];
        if (nloc == 0u) { xcd_barrier_complete(bar, b.x, nloc, nx); b.st[0] = nloc; b.st[1] = nx; }
        const unsigned old = xb_add(&bar[XB_XSUB(b.x)], 1u);
        const unsigned gen = old / nloc;
        if (old + 1u == (gen + 1u) * nloc) {
            __builtin_amdgcn_fence(__ATOMIC_RELEASE, "agent");
            asm volatile("s_waitcnt vmcnt(0)" ::: "memory");
            const unsigned og = xb_add(&bar[XB_TOP], 1u);
            const unsigned tg = og / nx;
            if (og + 1u == (tg + 1u) * nx) xb_add(&bar[XB_TOPGEN], 1u);
            else XB_SPIN(xb_ld(&bar[XB_TOPGEN]) == tg, bar);
            __builtin_amdgcn_fence(__ATOMIC_ACQUIRE, "agent");
            xb_add(&bar[XB_XGEN(b.x)], 1u);
            asm volatile("s_waitcnt vmcnt(0)" ::: "memory");
        } else {
            XB_SPIN(xb_ld(&bar[XB_XGEN(b.x)]) == gen, bar);
            __builtin_amdgcn_fence(__ATOMIC_ACQUIRE, "agent");
            asm volatile("s_waitcnt vmcnt(0)" ::: "memory");
        }
    }
    __syncthreads();
}
struct Args { const float* in[23]; float* out; unsigned char* ws; int ph_lo, ph_hi; };
enum { I_X = 0, I_F1PRE, I_F1GU, I_F1DN, I_F1POST, I_MIXPRE, I_WIN, I_CONVW, I_CONVB, I_WA, I_BA, I_WX, I_BX, I_LAM, I_SINK, I_WPL, I_WPA, I_WOUT, I_MIXPOST, I_F2PRE, I_F2GU, I_F2DN, I_F2POST };

__global__ void __launch_bounds__(NTHREADS, 2) fwd(Args a) {
    extern __shared__ __attribute__((aligned(16))) unsigned char lds_raw[];
    LAS unsigned char* lds = (LAS unsigned char*)lds_raw;
    cg::grid_group grid = cg::this_grid();
    const int tid = threadIdx.x, lane = tid & 63, wave = __builtin_amdgcn_readfirstlane(tid >> 6);
    const int G = gridDim.x, bx = blockIdx.x;
    const int gw = bx * NWAVES + wave, NGW = G * NWAVES;
    unsigned char* ws = a.ws;
    bf16* WGU = (bf16*)(ws + WS_WGU); bf16* WD = (bf16*)(ws + WS_WD); bf16* WIN = (bf16*)(ws + WS_WIN);
    bf16* WPL = (bf16*)(ws + WS_WPL); bf16* WPA = (bf16*)(ws + WS_WPA); bf16* WOUT = (bf16*)(ws + WS_WOUT);
    float* ROPE = (float*)(ws + WS_ROPE);
    bf16* XN = (bf16*)(ws + WS_XN); bf16* ACT = (bf16*)(ws + WS_ACT); bf16* F = (bf16*)(ws + WS_F);
    bf16* GB = (bf16*)(ws + WS_GB); bf16* XB = (bf16*)(ws + WS_XB); bf16* Qb = (bf16*)(ws + WS_Q); bf16* Kb = (bf16*)(ws + WS_K); bf16* Vb = (bf16*)(ws + WS_V);
    bf16* GL = (bf16*)(ws + WS_GL); bf16* GA = (bf16*)(ws + WS_GA); bf16* MB = (bf16*)(ws + WS_MB);
    float* H = a.out;
    const int lo = a.ph_lo, hi = a.ph_hi;
    volatile LAS unsigned* st = (volatile LAS unsigned*)(lds + MISC_OFF);
    if (tid < 16) st[tid] = 0u;
    __syncthreads();
    XcdBarrier bar = xcd_barrier_post((unsigned*)(ws + WS_CTL), st);
#define IN(k) (lo <= (k) && (k) < hi)
#define REPS(k) ((PROBE == 100 + (k)) ? 2 : 1)
#define SEAM(k) do { if (IN(k) && IN((k) + 1)) xcd_barrier(bar); if (TS_K == (k)) ts1 = __builtin_amdgcn_s_memrealtime(); } while (0)
    unsigned long long ts0 = 0, ts1 = 0; if (TS_K >= 0) ts0 = __builtin_amdgcn_s_memrealtime();
    if (lo < 0) grid.sync();

    if (IN(0)) for (int rep_ = 0; rep_ < REPS(0); ++rep_) {
        LAS float* scr = (LAS float*)(lds + wave * 16384);
        constexpr int I_GU = (D / 64) * (NGU / 32), I_DN = (DFF / 64) * (D / 32);
        for (int it = gw; it < I_GU + I_DN; it += NGW) {
            if (it < I_GU) transpose_item(a.in[I_F1GU], D, NGU, WGU, 1, scr, it, lane);
            else transpose_item(a.in[I_F1DN], DFF, D, WD, 0, scr, it - I_GU, lane);
        }
        for (int i = bx * NTHREADS + tid; i < SEQ * 32; i += G * NTHREADS) rope_entry(i, ROPE);
        norm_rows(a.in[I_X], a.in[I_F1PRE], XN, gw, NGW, lane);
    }
    SEAM(0);
    if (IN(1)) for (int rep_ = 0; rep_ < REPS(1); ++rep_) {
        __syncthreads();
        pg8::Gemm g{XN, WGU, M, NGU, D}; pg8::StaticOrder S; S.init(M, NGU, G, bx);
        pg8::EpiSwiglu E{ACT};
        pg8::gemm_phase<pg8::EpiSwiglu, pg8::StaticOrder, true, true>(lds, g, S, E);
        { const int rem = ((M / 256) * (NGU / 256)) % G, first = rem, nblk = G - rem;
          if (bx >= first) {
              LAS float* scr = (LAS float*)(lds + wave * 16384);
              constexpr int I_IN = (D / 64) * (NIN / 32), I_PR = (D / 64) * (D / 32);
              for (int it = (bx - first) * NWAVES + wave; it < I_IN + 3 * I_PR; it += nblk * NWAVES) {
                  int r = it;
                  if (r < I_IN) { transpose_item(a.in[I_WIN], D, NIN, WIN, 2, scr, r, lane); continue; } r -= I_IN;
                  if (r < I_PR) { transpose_item(a.in[I_WPL], D, D, WPL, 0, scr, r, lane); continue; } r -= I_PR;
                  if (r < I_PR) { transpose_item(a.in[I_WPA], D, D, WPA, 0, scr, r, lane); continue; } r -= I_PR;
                  transpose_item(a.in[I_WOUT], D, D, WOUT, 0, scr, r, lane);
              }
          } }
    }
    SEAM(1);
    if (IN(2)) for (int rep_ = 0; rep_ < REPS(2); ++rep_) {
        pg8::Gemm g{ACT, WD, M, D, DFF}; pg8::StaticOrder S; S.init(M, D, G, bx);
        pg8::EpiBf E{F, D};
        pg8::gemm_phase<pg8::EpiBf, pg8::StaticOrder, true, true>(lds, g, S, E);
    }
    SEAM(2);
    if (IN(3)) for (int rep_ = 0; rep_ < REPS(3); ++rep_) {
        resid_rows(F, a.in[I_X], H, XN, a.in[I_F1POST], a.in[I_MIXPRE], 0.5f, gw, NGW, lane);
    }
    SEAM(3);
    if (IN(4)) for (int rep_ = 0; rep_ < REPS(4); ++rep_) {
        __syncthreads();
        pg8::Gemm g{XN, WIN, M, NIN, D}; pg8::StaticOrder S; S.init(M, NIN, G, bx);
        pg8::EpiMix E{GB, XB, Qb, Kb, Vb, GL, GA, ROPE};
        pg8::gemm_phase<pg8::EpiMix, pg8::StaticOrder, true, true>(lds, g, S, E);
        { const int rem = ((M / 256) * (NIN / 256)) % G, first = rem, nblk = G - rem;
          if (bx >= first) {
              LAS float* scr = (LAS float*)(lds + wave * 16384);
              constexpr int I_GU = (D / 64) * (NGU / 32), I_DN = (DFF / 64) * (D / 32);
              for (int it = (bx - first) * NWAVES + wave; it < I_GU + I_DN; it += nblk * NWAVES) {
                  if (it < I_GU) transpose_item(a.in[I_F2GU], D, NGU, WGU, 1, scr, it, lane);
                  else transpose_item(a.in[I_F2DN], DFF, D, WD, 0, scr, it - I_GU, lane);
              }
          } }
    }
    SEAM(4);
    if (IN(5)) {
#if PROBE == 1
        for (int u = bx; u < BATCH * 16 * 2; u += G)
            rec_unit(lds, u, XB, GB, XN, a.in[I_CONVW], a.in[I_CONVB], a.in[I_WA], a.in[I_BA], a.in[I_WX], a.in[I_BX], a.in[I_LAM]);
#elif PROBE == 2
        for (int u = bx; u < BATCH * 16 * 4; u += G)
            attn_unit(lds, u, Qb, XN, Kb, Vb, a.in[I_SINK]);
#endif
        for (int u = bx; u < BATCH * 16 * 2; u += G)
            rec_unit(lds, u, XB, GB, GB, a.in[I_CONVW], a.in[I_CONVB], a.in[I_WA], a.in[I_BA], a.in[I_WX], a.in[I_BX], a.in[I_LAM]);
        for (int u = bx; u < BATCH * 16 * 4; u += G)
            attn_unit(lds, u, Qb, Qb, Kb, Vb, a.in[I_SINK]);
    }
    SEAM(5);
    if (IN(6)) for (int rep_ = 0; rep_ < REPS(6); ++rep_) {
        { pg8::Gemm g{GB, WPL, M, D, D}; pg8::StaticOrder S; S.init(M, D, G, bx);
          pg8::EpiGate<false> E{GL, MB};
          pg8::gemm_phase<pg8::EpiGate<false>, pg8::StaticOrder, true, true>(lds, g, S, E); }
        __syncthreads();
        { pg8::Gemm g{Qb, WPA, M, D, D}; pg8::StaticOrder S; S.init(M, D, G, bx);
          pg8::EpiGate<true> E{GA, MB};
          pg8::gemm_phase<pg8::EpiGate<true>, pg8::StaticOrder, true, true>(lds, g, S, E); }
    }
    SEAM(6);
    if (IN(7)) for (int rep_ = 0; rep_ < REPS(7); ++rep_) {
        pg8::Gemm g{MB, WOUT, M, D, D}; pg8::StaticOrder S; S.init(M, D, G, bx);
        pg8::EpiBf E{F, D};
        pg8::gemm_phase<pg8::EpiBf, pg8::StaticOrder, true, true>(lds, g, S, E);
    }
    SEAM(7);
    if (IN(8)) resid_rows(F, H, H, XN, a.in[I_MIXPOST], a.in[I_F2PRE], 1.0f, gw, NGW, lane);
    SEAM(8);
    if (IN(9)) for (int rep_ = 0; rep_ < REPS(9); ++rep_) {
        pg8::Gemm g{XN, WGU, M, NGU, D}; pg8::StaticOrder S; S.init(M, NGU, G, bx);
        pg8::EpiSwiglu E{ACT};
        pg8::gemm_phase<pg8::EpiSwiglu, pg8::StaticOrder, true, true>(lds, g, S, E);
    }
    SEAM(9);
    if (IN(10)) for (int rep_ = 0; rep_ < REPS(10); ++rep_) {
        pg8::Gemm g{ACT, WD, M, D, DFF}; pg8::StaticOrder S; S.init(M, D, G, bx);
        pg8::EpiBf E{F, D};
        pg8::gemm_phase<pg8::EpiBf, pg8::StaticOrder, true, true>(lds, g, S, E);
    }
    SEAM(10);
    if (IN(11)) resid_rows(F, H, H, nullptr, a.in[I_F2POST], nullptr, 0.5f, gw, NGW, lane);
#if TS_K >= 0
    if (TS_K == 99) ts1 = __builtin_amdgcn_s_memrealtime();
    if (gw == 0) { const float delta = (float)(ts1 - ts0) * 0.01f * 1.5e-4f;
        asm volatile("s_waitcnt vmcnt(0)" ::: "memory");
        for (int j = 0; j < 16; ++j) H[lane + 64 * j] += delta; }
#endif
#undef IN
#undef SEAM
}

#ifndef MK_PER_PHASE_DUMMY
#define MK_PER_PHASE 0
#endif
extern "C" void kernel_launch(void* const* d_in, const int* in_sizes, int n_in, void* d_out, int out_size, void* d_ws, size_t ws_size, hipStream_t stream) {
    static int grid = 0;
    if (grid == 0) {
        if (n_in != 23 || out_size != M * D || ws_size < WS_CTL + CTL_BYTES) { fprintf(stderr, "kernel_launch: unexpected shapes (n_in %d out %d ws %zu)\n", n_in, out_size, ws_size); grid = -1; return; }
        int dev = 0, cus = 0, per_cu = 0;
        if (hipGetDevice(&dev) != hipSuccess || hipDeviceGetAttribute(&cus, hipDeviceAttributeMultiprocessorCount, dev) != hipSuccess) { grid = -1; return; }
        if (hipFuncSetAttribute((const void*)fwd, hipFuncAttributeMaxDynamicSharedMemorySize, LDS_BYTES) != hipSuccess) { fprintf(stderr, "kernel_launch: hipFuncSetAttribute failed\n"); grid = -1; return; }
        if (hipOccupancyMaxActiveBlocksPerMultiprocessor(&per_cu, (const void*)fwd, NTHREADS, LDS_BYTES) != hipSuccess || per_cu < 1) per_cu = 1;
        (void)hipGetLastError();
        grid = cus * per_cu;
        fprintf(stderr, "kernel_launch: grid %d (cus %d x %d), ws %zu\n", grid, cus, per_cu, ws_size);
    }
    if (grid < 0) return;
    if (hipMemsetAsync((char*)d_ws + WS_CTL, 0, CTL_BYTES, stream) != hipSuccess) { fprintf(stderr, "kernel_launch: memset failed\n"); return; }
    Args a{};
    for (int i = 0; i < 23; ++i) a.in[i] = (const float*)d_in[i];
    a.out = (float*)d_out; a.ws = (unsigned char*)d_ws;
#if MK_PER_PHASE
    for (int p = 0; p < 12; ++p) { a.ph_lo = p; a.ph_hi = p + 1; hipLaunchKernelGGL(fwd, dim3(grid), dim3(NTHREADS), LDS_BYTES, stream, a); }
#else
    a.ph_lo = 0; a.ph_hi = 12;
    void* args[] = {&a};
    hipError_t e = hipLaunchCooperativeKernel((const void*)fwd, dim3(grid), dim3(NTHREADS), args, LDS_BYTES, stream);
    if (e != hipSuccess) fprintf(stderr, "kernel_launch: cooperative launch failed: %s (grid %d)\n", hipGetErrorString(e), grid);
#endif
}
```
